# Optimizing an MI355X kernel written in HIP

```python
import jax, jax.numpy as jnp
from jax import lax
import numpy as np

D_MODEL = 1024
BATCH = 8
SEQ = 2048
DEPTH = 1
DEC_BATCH = 128
DEC_SEQ = 1
PAST_LEN = 16384
PAGE_SIZE = 128

D_MIX = 2 * D_MODEL
D_A = D_MIX // 2
D_B = D_MIX - D_A
CHUNK = 128
HD_A = 128
H_A = D_A // HD_A
H_B = 8
CONV_W = 3
EPS = 1e-5
SPLIT_SIZES = (D_A, D_A, D_A, D_B, D_B, D_B, D_B)
SPLIT_IDX = tuple(int(i) for i in np.cumsum(SPLIT_SIZES)[:-1])
D_IN = sum(SPLIT_SIZES)

kernel_name = "hymba_chunk_gmlp_shortconv_step"


def rmsnorm(x, g):
    xf = x.astype(jnp.float32)
    inv = lax.rsqrt(jnp.mean(xf * xf, axis=-1, keepdims=True) + EPS)
    return (xf * inv * g.astype(jnp.float32)).astype(x.dtype)


def chunk_mix(v, w_s, b_s):
    n, t = v.shape[0], v.shape[1]
    pad = (-t) % CHUNK
    vp = jnp.pad(v, ((0, 0), (0, pad), (0, 0), (0, 0)))
    nc = (t + pad) // CHUNK
    vp = vp.reshape(n, nc, CHUNK, H_A, HD_A)
    mask = jnp.tril(jnp.ones((CHUNK, CHUNK), dtype=w_s.dtype))
    w = w_s * mask[None]
    out = jnp.einsum('hts,ncshd->ncthd', w, vp)
    out = out + jnp.transpose(b_s)[None, None, :, :, None]
    return out.reshape(n, nc * CHUNK, H_A, HD_A)[:, :t]


def mixer_layer(x, conv_state, g_norm, w_in, w_s, b_s, g_v, conv_w, w_out):
    n, t = x.shape[0], x.shape[1]
    h = rmsnorm(x, g_norm)
    proj = jnp.einsum('btd,de->bte', h, w_in)
    u, v, z_a, x_b, gate_b, gate_c, z_b = jnp.split(proj, SPLIT_IDX, axis=-1)
    u = jax.nn.gelu(u, approximate=False)
    v = rmsnorm(jax.nn.gelu(v, approximate=False), g_v)
    mixed = chunk_mix(v.reshape(n, t, H_A, HD_A), w_s, b_s).reshape(n, t, D_A)
    out_a = u * mixed * jax.nn.silu(z_a)
    hb = gate_c * x_b
    hb_ext = jnp.concatenate([conv_state.astype(hb.dtype), hb], axis=1)
    conv = hb_ext[:, 0:t] * conv_w[0]
    for k in range(1, CONV_W):
        conv = conv + hb_ext[:, k:k + t] * conv_w[k]
    out_b = gate_b * conv * jax.nn.silu(z_b)
    mix = jnp.concatenate([out_a, out_b], axis=-1)
    y = x + jnp.einsum('bte,ed->btd', mix, w_out)
    new_conv = hb_ext[:, t:]
    return y, new_conv, v


def setup_inputs(seed: int = 0) -> dict:
    key = jax.random.key(seed)
    ks = jax.random.split(key, 12)
    f32 = jnp.float32
    x_prompt = jax.random.normal(ks[0], (BATCH, SEQ, D_MODEL), f32)
    x_sample = jax.random.normal(ks[1], (DEC_BATCH, DEC_SEQ, D_MODEL), f32)
    state_conv = jax.random.normal(ks[2], (DEPTH, DEC_BATCH, CONV_W - 1, D_B), f32)
    g_norm = 1.0 + 0.02 * jax.random.normal(ks[3], (DEPTH, D_MODEL), f32)
    w_in = jax.random.normal(ks[4], (DEPTH, D_MODEL, D_IN), f32) * D_MODEL ** -0.5
    w_s = jax.random.normal(ks[5], (DEPTH, H_A, CHUNK, CHUNK), f32) * (0.5 * CHUNK ** -0.5)
    b_s = 1.0 + 0.1 * jax.random.normal(ks[6], (DEPTH, H_A, CHUNK), f32)
    g_v = 1.0 + 0.02 * jax.random.normal(ks[7], (DEPTH, D_A), f32)
    conv_w = jax.random.normal(ks[8], (DEPTH, CONV_W, D_B), f32) * CONV_W ** -0.5
    w_out = jax.random.normal(ks[9], (DEPTH, D_MIX, D_MODEL), f32) * D_MIX ** -0.5
    g_final = 1.0 + 0.02 * jax.random.normal(ks[10], (D_MODEL,), f32)
    return {"x_prompt": x_prompt, "x_sample": x_sample, "state_conv": state_conv,
            "g_norm": g_norm, "w_in": w_in, "w_s": w_s, "b_s": b_s, "g_v": g_v,
            "conv_w": conv_w, "w_out": w_out, "g_final": g_final}


def reference(x_prompt, x_sample, state_conv, g_norm, w_in, w_s, b_s, g_v, conv_w, w_out, g_final):
    xp, xs = x_prompt, x_sample
    conv_p_list, conv_s_list, v_s_list = [], [], []
    for l in range(DEPTH):
        zero_state = jnp.zeros((xp.shape[0], CONV_W - 1, D_B), xp.dtype)
        xp, conv_p, _ = mixer_layer(xp, zero_state, g_norm[l], w_in[l], w_s[l], b_s[l],
                                    g_v[l], conv_w[l], w_out[l])
        xs, conv_s, v_s = mixer_layer(xs, state_conv[l], g_norm[l], w_in[l], w_s[l], b_s[l],
                                      g_v[l], conv_w[l], w_out[l])
        conv_p_list.append(conv_p)
        conv_s_list.append(conv_s)
        v_s_list.append(v_s)
    y_prompt = rmsnorm(xp, g_final)
    y_sample = rmsnorm(xs, g_final)
    state_conv_prompt = jnp.stack(conv_p_list, axis=0)
    state_conv_sample = jnp.stack(conv_s_list, axis=0)
    state_v_sample = jnp.stack(v_s_list, axis=0)
    return (y_prompt, y_sample, state_conv_prompt, state_conv_sample, state_v_sample)
```

```cpp
#include <hip/hip_runtime.h>
#include <hip/hip_cooperative_groups.h>
#include <cstdio>
#include <cstdint>
namespace cg = cooperative_groups;

#ifndef PROBE_SYNC2
#define PROBE_SYNC2 0
#endif
#ifndef PROBE_P2X2
#define PROBE_P2X2 0
#endif
#ifndef MK_N_LAUNCHES
#define MK_N_LAUNCHES 1
#endif

namespace pg8 {
#define PG8_LAS __attribute__((address_space(3)))
typedef unsigned short bf16_t;
typedef short bf16x8 __attribute__((ext_vector_type(8)));
typedef float f32x4 __attribute__((ext_vector_type(4)));
typedef float f32x2 __attribute__((ext_vector_type(2)));
typedef unsigned u32x4 __attribute__((ext_vector_type(4)));
typedef unsigned u32x2 __attribute__((ext_vector_type(2)));
constexpr int BM = 256, BK = 64, HALF = 128, HTB = HALF * BK * 2, STAGE_BYTES = 8 * HTB, NXCD = 8, WGM = 8;

__host__ __device__ __forceinline__ int lds_byte(int r, int c) { const int st = (r >> 4) * 2 + (c >> 5), rr = r & 15, cc = c & 31, ob = rr * 64 + cc * 2; return st * 1024 + (ob ^ (((ob >> 9) & 1) << 5)); }
__host__ __device__ __forceinline__ void stage_rc(int b, int& R, int& C) { const int st = b / 1024, sb = b % 1024, swz = sb ^ (((sb >> 9) & 1) << 5); R = (st >> 1) * 16 + swz / 64; C = (st & 1) * 32 + (swz % 64) / 2; }
__host__ __device__ __forceinline__ int perm32(int rho) { const int n = rho >> 4, i = rho & 15; return 8 * (i >> 2) + 4 * n + (i & 3); }

struct Unit { int pm, pn; };
struct Gemm { const bf16_t* A; const bf16_t* Bt; int M, N, K; };

struct StaticOrder {
    int nM, nN, nwg, G, c;
    __host__ __device__ void init(int M, int N, int G_, int c_) { nM = M / BM; nN = N / BM; nwg = nM * nN; G = G_; c = c_; }
    __host__ __device__ bool next(int i, Unit& u) const {
        const long L = (long)i * G + c; if (L >= nwg) return false;
        int wgid = (int)L; { const int q = nwg / NXCD, r = nwg % NXCD, xcd = wgid % NXCD, off = wgid / NXCD; wgid = (xcd < r ? xcd * (q + 1) : r * (q + 1) + (xcd - r) * q) + off; }
        const int nig = WGM * nN, gid = wgid / nig, fm = gid * WGM, gsz = (nM - fm) < WGM ? (nM - fm) : WGM;
        u.pm = fm + ((wgid % nig) % gsz); u.pn = (wgid % nig) / gsz; return true;
    }
    __device__ __forceinline__ void ptrs(const Gemm& g, const Unit& u, size_t tstep, const char*& a, const char*& b) const {
        a = (const char*)g.A + (size_t)u.pm * tstep; b = (const char*)g.Bt + (size_t)u.pn * tstep;
    }
};
struct OrderG1 : StaticOrder {
    __device__ __forceinline__ void ptrs(const Gemm& g, const Unit& u, size_t tstep, const char*& a, const char*& b) const {
        const char* pa = (const char*)g.A + (size_t)u.pm * tstep; const char* pb = (const char*)g.Bt + (size_t)u.pn * tstep;
        const bool sw = (u.pn < 4);
        a = sw ? pb : pa; b = sw ? pa : pb;
    }
};

__device__ __forceinline__ unsigned cvt_pk_bf16(float lo, float hi) { unsigned r; asm volatile("v_cvt_pk_bf16_f32 %0, %1, %2" : "=v"(r) : "v"(lo), "v"(hi)); return r; }
__device__ __forceinline__ f32x2 gelu_pk(f32x2 v) {
    const f32x2 av = __builtin_elementwise_abs(v), d = av * 0.2316418882f + 1.0f;
    f32x2 t; t.x = __builtin_amdgcn_rcpf(d.x); t.y = __builtin_amdgcn_rcpf(d.y);
    f32x2 q = t * 0.5307027145f + (-0.7265760135f); q = q * t + 0.7107068705f; q = q * t + (-0.142248368f); q = q * t + 0.127414796f; q = q * t;
    const f32x2 s = (v * v) * (-0.72134752044f);
    f32x2 e; e.x = __builtin_amdgcn_exp2f(s.x); e.y = __builtin_amdgcn_exp2f(s.y);
    const f32x2 m = v * (q * e), r = v - m;
    f32x2 o; o.x = v.x < 0.f ? m.x : r.x; o.y = v.y < 0.f ? m.y : r.y; return o;
}
__device__ __forceinline__ f32x4 gelu4(f32x4 v) { const f32x2 a = gelu_pk((f32x2){v[0], v[1]}), b = gelu_pk((f32x2){v[2], v[3]}); return (f32x4){a.x, a.y, b.x, b.y}; }
__device__ __forceinline__ float silu1(float z) { return z * __builtin_amdgcn_rcpf(1.0f + __builtin_amdgcn_exp2f(z * -1.44269504089f)); }
__device__ __forceinline__ f32x4 silu4(f32x4 v) { return (f32x4){silu1(v[0]), silu1(v[1]), silu1(v[2]), silu1(v[3])}; }

template <class Epi, class Sched, bool ALIGN_EPI = false, bool SP2 = false>
__device__ __forceinline__ void gemm_phase(PG8_LAS unsigned char* lds, const Gemm g, const Sched& S, const Epi& E) {
    const int tid = threadIdx.x, wid = __builtin_amdgcn_readfirstlane(tid >> 6), lane = tid & 63, wr = wid >> 2, wc = wid & 3, fr = lane & 15, fq = lane >> 4;
    const int K = g.K, nt = K / BK;
    unsigned voffA[2], voffB[2];
#pragma unroll
    for (int i = 0; i < 2; ++i) { int R, C; stage_rc(tid * 16 + i * 8192, R, C); const int Rb = Epi::PERM ? ((R & ~31) + perm32(R & 31)) : R;
        voffA[i] = (unsigned)(R * K + C) * 2u; voffB[i] = (unsigned)(Rb * K + C) * 2u; }
    const size_t kstep = (size_t)(BK * 2);
    const size_t hstep = (size_t)HALF * K * 2;
    const size_t tstep = 2 * hstep;
    const unsigned ldsw = (unsigned)wid * 1024u;
    const int aoff = lds_byte(wr * 64 + fr, fq * 8), boff = lds_byte(wc * 32 + fr, fq * 8);
#define PG8_SA(b, h) (((b) * 2 + (h)) * HTB)
#define PG8_SB(b, h) ((4 + (b) * 2 + (h)) * HTB)
#define PG8_STAGE(bufoff, gbase, voff) do { _Pragma("unroll") for (int _i = 0; _i < 2; ++_i) \
        __builtin_amdgcn_global_load_lds((const unsigned*)((const char*)(gbase) + (voff)[_i]), (PG8_LAS unsigned*)(lds + (bufoff) + ldsw + _i * 8192), 16, 0, 0); } while (0)
#define PG8_LDA(dst, b, h) do { _Pragma("unroll") for (int m = 0; m < 4; ++m) _Pragma("unroll") for (int k = 0; k < 2; ++k) dst[m][k] = *(const PG8_LAS bf16x8*)(lds + PG8_SA(b, h) + aoff + m * 2048 + k * 1024); } while (0)
#define PG8_LDB(dst, b, h) do { _Pragma("unroll") for (int n = 0; n < 2; ++n) _Pragma("unroll") for (int k = 0; k < 2; ++k) dst[n][k] = *(const PG8_LAS bf16x8*)(lds + PG8_SB(b, h) + boff + n * 2048 + k * 1024); } while (0)
#define PG8_MMA(ai, bj, At, Bt) do { __builtin_amdgcn_s_setprio(1); _Pragma("unroll") for (int m = 0; m < 4; ++m) _Pragma("unroll") for (int n = 0; n < 2; ++n) _Pragma("unroll") for (int k = 0; k < 2; ++k) \
        acc[ai][bj][m][n] = __builtin_amdgcn_mfma_f32_16x16x32_bf16(Bt[n][k], At[m][k], acc[ai][bj][m][n], 0, 0, 0); __builtin_amdgcn_s_setprio(0); } while (0)
#define PG8_WAIT_V(n) asm volatile("s_waitcnt vmcnt(" #n ")" ::: "memory")
#define PG8_WAIT_L(n) asm volatile("s_waitcnt lgkmcnt(" #n ")" ::: "memory")
#define PG8_BAR __builtin_amdgcn_s_barrier()
#define PG8_SCHED __builtin_amdgcn_sched_barrier(0)
    Unit cur, nxt; int ui = 0;
    if (!S.next(0, cur)) return;
    f32x4 acc[2][2][4][2];
#pragma unroll
    for (int a = 0; a < 2; ++a)
#pragma unroll
        for (int b = 0; b < 2; ++b)
#pragma unroll
            for (int m = 0; m < 4; ++m)
#pragma unroll
                for (int n = 0; n < 2; ++n) acc[a][b][m][n] = (f32x4){0.f, 0.f, 0.f, 0.f};
    bf16x8 At[4][2], B0[2][2], B1[2][2];
    const char* cA; const char* cB; S.ptrs(g, cur, tstep, cA, cB);
    if constexpr (SP2) {
        PG8_STAGE(PG8_SB(0, 0), cB, voffB); PG8_STAGE(PG8_SB(0, 1), cB + hstep, voffB); PG8_STAGE(PG8_SA(0, 0), cA, voffA); PG8_STAGE(PG8_SA(0, 1), cA + hstep, voffA);
        if (wr == 1) PG8_BAR;
        PG8_WAIT_V(2); PG8_BAR;
        PG8_STAGE(PG8_SB(1, 0), cB + kstep, voffB); PG8_STAGE(PG8_SA(1, 0), cA + kstep, voffA); PG8_STAGE(PG8_SB(1, 1), cB + hstep + kstep, voffB);
        PG8_WAIT_V(6); PG8_BAR;
    } else {
        PG8_STAGE(PG8_SB(0, 0), cB, voffB); PG8_STAGE(PG8_SA(0, 0), cA, voffA); PG8_STAGE(PG8_SB(0, 1), cB + hstep, voffB); PG8_STAGE(PG8_SA(0, 1), cA + hstep, voffA);
        if (wr == 1) PG8_BAR;
        PG8_WAIT_V(4); PG8_BAR;
        PG8_STAGE(PG8_SB(1, 0), cB + kstep, voffB); PG8_STAGE(PG8_SA(1, 0), cA + kstep, voffA); PG8_STAGE(PG8_SB(1, 1), cB + hstep + kstep, voffB);
        PG8_WAIT_V(6); PG8_BAR;
    }
    for (;;) {
        const bool has_next = S.next(ui + 1, nxt);
        const char* nA = cA; const char* nB = cB; if (has_next) S.ptrs(g, nxt, tstep, nA, nB);
        for (int t = 0; t < nt; t += 2) {
            const bool last = (t == nt - 2);
            const char* a1 = cA + (size_t)(t + 1) * kstep;
            const char* a2 = last ? nA : cA + (size_t)(t + 2) * kstep; const char* b2 = last ? nB : cB + (size_t)(t + 2) * kstep;
            const char* a3 = a2 + kstep; const char* b3 = b2 + kstep;
            if constexpr (SP2) {
            PG8_LDB(B0, 0, 0); PG8_LDB(B1, 0, 1); PG8_SCHED; PG8_LDA(At, 0, 0); PG8_STAGE(PG8_SA(1, 1), a1 + hstep, voffA);
            PG8_WAIT_V(8); PG8_WAIT_L(0); PG8_BAR; PG8_MMA(0, 0, At, B0); PG8_MMA(0, 1, At, B1); PG8_BAR; PG8_SCHED;
            PG8_LDA(At, 0, 1); PG8_STAGE(PG8_SB(0, 0), b2, voffB); PG8_STAGE(PG8_SB(0, 1), b2 + hstep, voffB); PG8_STAGE(PG8_SA(0, 0), a2, voffA);
            PG8_WAIT_V(8); PG8_WAIT_L(0); PG8_BAR; PG8_MMA(1, 0, At, B0); PG8_MMA(1, 1, At, B1); PG8_BAR; PG8_SCHED;
            PG8_LDB(B0, 1, 0); PG8_LDB(B1, 1, 1); PG8_SCHED; PG8_LDA(At, 1, 0); PG8_STAGE(PG8_SA(0, 1), a2 + hstep, voffA);
            PG8_WAIT_V(8); PG8_WAIT_L(0); PG8_BAR; PG8_MMA(0, 0, At, B0); PG8_MMA(0, 1, At, B1); PG8_BAR; PG8_SCHED;
            PG8_LDA(At, 1, 1); PG8_STAGE(PG8_SB(1, 0), b3, voffB); PG8_STAGE(PG8_SB(1, 1), b3 + hstep, voffB); PG8_STAGE(PG8_SA(1, 0), a3, voffA);
            PG8_WAIT_V(8); PG8_WAIT_L(0); PG8_BAR; PG8_MMA(1, 0, At, B0); PG8_MMA(1, 1, At, B1); PG8_BAR; PG8_SCHED;
            } else {
            PG8_LDB(B0, 0, 0); PG8_SCHED; PG8_LDA(At, 0, 0); PG8_STAGE(PG8_SA(1, 1), a1 + hstep, voffA);
            PG8_WAIT_L(8); PG8_BAR; PG8_WAIT_L(0); PG8_MMA(0, 0, At, B0); PG8_BAR; PG8_SCHED;
            PG8_LDB(B1, 0, 1); PG8_STAGE(PG8_SB(0, 0), b2, voffB);
            PG8_BAR; PG8_WAIT_L(0); PG8_MMA(0, 1, At, B1); PG8_BAR;
            PG8_LDA(At, 0, 1); PG8_STAGE(PG8_SA(0, 0), a2, voffA);
            PG8_BAR; PG8_WAIT_L(0); PG8_MMA(1, 0, At, B0); PG8_BAR; PG8_SCHED;
            PG8_STAGE(PG8_SB(0, 1), b2 + hstep, voffB);
            PG8_WAIT_V(6); PG8_BAR; PG8_MMA(1, 1, At, B1); PG8_BAR;
            PG8_LDB(B0, 1, 0); PG8_SCHED; PG8_LDA(At, 1, 0); PG8_STAGE(PG8_SA(0, 1), a2 + hstep, voffA);
            PG8_WAIT_L(8); PG8_BAR; PG8_WAIT_L(0); PG8_MMA(0, 0, At, B0); PG8_BAR; PG8_SCHED;
            PG8_LDB(B1, 1, 1); PG8_STAGE(PG8_SB(1, 0), b3, voffB);
            PG8_BAR; PG8_WAIT_L(0); PG8_MMA(0, 1, At, B1); PG8_BAR;
            PG8_LDA(At, 1, 1); PG8_STAGE(PG8_SA(1, 0), a3, voffA);
            PG8_BAR; PG8_WAIT_L(0); PG8_MMA(1, 0, At, B0); PG8_BAR; PG8_SCHED;
            PG8_STAGE(PG8_SB(1, 1), b3 + hstep, voffB);
            PG8_WAIT_V(6); PG8_BAR; PG8_MMA(1, 1, At, B1); PG8_BAR;
            }
        }
        if constexpr (ALIGN_EPI) { if (wr == 0) PG8_BAR; }
        if constexpr (!Epi::AFTER_DRAIN) E(acc, cur, wr, wc, fr, fq);
        if (!has_next) break;
#pragma unroll
        for (int a = 0; a < 2; ++a)
#pragma unroll
            for (int b = 0; b < 2; ++b)
#pragma unroll
                for (int m = 0; m < 4; ++m)
#pragma unroll
                    for (int n = 0; n < 2; ++n) acc[a][b][m][n] = (f32x4){0.f, 0.f, 0.f, 0.f};
        cur = nxt; cA = nA; cB = nB; ++ui;
        if constexpr (ALIGN_EPI) { if (wr == 1) PG8_BAR; }
    }
    PG8_WAIT_V(0);
    if constexpr (!ALIGN_EPI) { if (wr == 0) PG8_BAR; }
    PG8_BAR;
    if constexpr (Epi::AFTER_DRAIN) E.fused(acc, cur, wr, wc, fr, fq, lds);
#undef PG8_SA
#undef PG8_SB
#undef PG8_STAGE
#undef PG8_LDA
#undef PG8_LDB
#undef PG8_MMA
#undef PG8_WAIT_V
#undef PG8_WAIT_L
#undef PG8_BAR
#undef PG8_SCHED
}
}

using pg8::bf16_t; using pg8::bf16x8; using pg8::f32x4; using pg8::f32x2; using pg8::u32x4; using pg8::u32x2;
constexpr int DM = 1024, SEQ = 2048, NTOK_P = 16384, NSMP = 128, NTOK = NTOK_P + NSMP, MPAD = 16640, DIN = 7168, DMIX = 2048;
constexpr int N1A = 3072, N1B = 4096;
constexpr float EPS = 1e-5f;
constexpr int NWAVES = 8;
constexpr int XCD_BAR_WORDS_C = 3456;
constexpr size_t MiB = 1u << 20, KiB = 1u << 10;
constexpr size_t WS_VSS = 0, WS_YSS = (size_t)MPAD * 4;
constexpr size_t WS_BAR = 256 * KiB, BAR_BYTES = 65536;
static_assert(WS_YSS + (size_t)MPAD * 4 <= WS_BAR && XCD_BAR_WORDS_C * 4 <= BAR_BYTES, "ctl map");
constexpr size_t WS_BT1 = 1 * MiB, WS_BT2 = 15 * MiB, WS_WSB = 19 * MiB, WS_PAS = 19 * MiB + 512 * KiB, WS_HBS = WS_PAS + 256 * KiB, WS_QBS = WS_HBS + 256 * KiB, WS_GVS = WS_QBS + 256 * KiB;
constexpr size_t WS_XN = 21 * MiB, WS_HB = 54 * MiB, WS_GVTF = 86 * MiB, WS_MIX = 118 * MiB, WS_END = 183 * MiB;
static_assert(WS_BT1 + (size_t)DIN * DM * 2 <= WS_BT2 && WS_BT2 + (size_t)DM * DMIX * 2 <= WS_WSB && WS_WSB + 8 * 128 * 128 * 2 <= WS_PAS && WS_GVS + 256 * KiB <= WS_XN && WS_XN + (size_t)NTOK * DM * 2 <= WS_HB &&
              WS_HB + (size_t)NTOK_P * DM * 2 <= WS_GVTF && WS_GVTF + (size_t)NTOK_P * DM * 2 <= WS_MIX && WS_MIX + (size_t)NTOK * DMIX * 2 <= WS_END, "ws map");
constexpr int LDS_BYTES = 133120 + 20480;
constexpr int WFR_OFF = 133120;


#define LAS __attribute__((address_space(3)))
#define LDS_WAIT() asm volatile("s_waitcnt lgkmcnt(0)" ::: "memory")
__device__ __forceinline__ float bf_lo(unsigned u) { return __uint_as_float(u << 16); }
__device__ __forceinline__ float bf_hi(unsigned u) { return __uint_as_float(u & 0xffff0000u); }
__device__ __forceinline__ float wave_sum(float v) {
#pragma unroll
    for (int o = 1; o < 64; o <<= 1) v += __shfl_xor(v, o);
    return v;
}


#define XB_TMO      128
#define XB_XCNT(j)  (256  + 64 * (j))
#define XB_XSUB(j)  (1280 + 64 * (j))
#define XB_XGEN(j)  (2304 + 64 * (j))
#define XB_TOP      3328
#define XB_TOPGEN   3392
#define XCD_BAR_WORDS 3456
#define XB_SPIN_CAP (1u << 18)
__device__ __forceinline__ unsigned xb_ld(unsigned* p)              { return __hip_atomic_load(p, __ATOMIC_RELAXED, __HIP_MEMORY_SCOPE_AGENT); }
__device__ __forceinline__ unsigned xb_add(unsigned* p, unsigned v) { return __hip_atomic_fetch_add(p, v, __ATOMIC_RELAXED, __HIP_MEMORY_SCOPE_AGENT); }
__device__ __forceinline__ unsigned xb_xcc_id() { return (unsigned)__builtin_amdgcn_s_getreg((3 << 11) | 20) & 0xFu; }
#define XB_SPIN(cond, bar) do { unsigned _sp = 0; while (cond) { __builtin_amdgcn_s_sleep(1); \
    if ((++_sp & 255u) == 0u) { if (xb_ld(&(bar)[XB_TMO])) break; if (_sp > XB_SPIN_CAP) { atomicAdd(&(bar)[XB_TMO], 1u); break; } } } } while (0)
struct XcdBarrier { unsigned* bar; unsigned x; volatile LAS unsigned* st; };
__device__ __forceinline__ XcdBarrier xcd_barrier_post(unsigned* bar, volatile LAS unsigned* st) {
    XcdBarrier b; b.bar = bar; b.x = xb_xcc_id(); b.st = st;
    if (threadIdx.x == 0) (void)xb_add(&bar[XB_XCNT(b.x)], 1u);
    return b;
}
__device__ __forceinline__ void xcd_barrier_complete(unsigned* bar, unsigned x, unsigned& nloc, unsigned& nx) {
    const unsigned G = gridDim.x * gridDim.y * gridDim.z;
    unsigned sum, cnt, mine, sp = 0u;
    for (;;) {
        sum = 0u; cnt = 0u; mine = 0u;
#pragma unroll
        for (unsigned j = 0; j < 16; ++j) { const unsigned c = xb_ld(&bar[XB_XCNT(j)]); sum += c; cnt += (c > 0u) ? 1u : 0u; mine = (j == x) ? c : mine; }
        if (sum == G) break;
        __builtin_amdgcn_s_sleep(1);
        if ((++sp & 255u) == 0u) { if (xb_ld(&bar[XB_TMO])) break; if (sp > XB_SPIN_CAP) { atomicAdd(&bar[XB_TMO], 1u); break; } }
    }
    nloc = mine > 0u ? mine : 1u; nx = cnt > 0u ? cnt : 1u;
}
__device__ __forceinline__ void xcd_barrier(const XcdBarrier& b) {
    asm volatile("s_waitcnt vmcnt(0)" ::: "memory");
    __syncthreads();
    if (threadIdx.x == 0) {
        unsigned* bar = b.bar;
        __builtin_amdgcn_s_waitcnt(0);
        unsigned nloc = b.st[0], nx = b.st[1];
        if (nloc == 0u) { xcd_barrier_complete(bar, b.x, nloc, nx); b.st[0] = nloc; b.st[1] = nx; }
        const unsigned old = xb_add(&bar[XB_XSUB(b.x)], 1u);
        const unsigned gen = old / nloc;
        if (old + 1u == (gen + 1u) * nloc) {
            __builtin_amdgcn_fence(__ATOMIC_RELEASE, "agent");
            asm volatile("s_waitcnt vmcnt(0)" ::: "memory");
            const unsigned og = xb_add(&bar[XB_TOP], 1u);
            const unsigned tg = og / nx;
            if (og + 1u == (tg + 1u) * nx) xb_add(&bar[XB_TOPGEN], 1u);
            else XB_SPIN(xb_ld(&bar[XB_TOPGEN]) == tg, bar);
            __builtin_amdgcn_fence(__ATOMIC_ACQUIRE, "agent");
            xb_add(&bar[XB_XGEN(b.x)], 1u);
            asm volatile("s_waitcnt vmcnt(0)" ::: "memory");
        } else {
            XB_SPIN(xb_ld(&bar[XB_XGEN(b.x)]) == gen, bar);
            __builtin_amdgcn_fence(__ATOMIC_ACQUIRE, "agent");
            asm volatile("s_waitcnt vmcnt(0)" ::: "memory");
        }
    }
    __syncthreads();
}


__device__ __forceinline__ void st16_wt(void* p, pg8::u32x4 v) { asm volatile("global_store_dwordx4 %0, %1, off sc1\n\ts_nop 1" :: "v"(p), "v"(v) : "memory"); }
__device__ __forceinline__ void st8_wt(void* p, unsigned long long v) { asm volatile("global_store_dwordx2 %0, %1, off sc1\n\ts_nop 1" :: "v"(p), "v"(v) : "memory"); }

struct EpiG1a {
    static constexpr bool PERM = true, AFTER_DRAIN = false;
    bf16_t* HB; bf16_t* GVTF; float* vss; PG8_LAS float* xch;
    __device__ __forceinline__ void operator()(const f32x4 (&acc)[2][2][4][2], const pg8::Unit& u, int wr, int wc, int fr, int fq) const {
        const int pn = u.pn;
        if (pn < 4) {
            const int vt = pn;
            float ss[2][2][4];
#pragma unroll
            for (int bj = 0; bj < 2; ++bj)
#pragma unroll
                for (int n = 0; n < 2; ++n)
#pragma unroll
                    for (int j = 0; j < 4; ++j) ss[bj][n][j] = 0.f;
            const int cn = (fr >> 2) & 1;
#pragma unroll
            for (int ai = 0; ai < 2; ++ai)
#pragma unroll
                for (int m = 0; m < 4; ++m) {
                    const int ch = vt * 2 + ai, cwc = wr * 2 + (m >> 1), cfr = 4 * ((m & 1) * 2 + (fr >> 3)) + (fr & 3);
#pragma unroll
                    for (int bj = 0; bj < 2; ++bj) {
                        const f32x4 g0 = pg8::gelu4(acc[ai][bj][m][0]), g1 = pg8::gelu4(acc[ai][bj][m][1]);
#pragma unroll
                        for (int j = 0; j < 4; ++j) { ss[bj][0][j] += g0[j] * g0[j]; ss[bj][1][j] += g1[j] * g1[j]; }
                        u32x4 w; w.x = pg8::cvt_pk_bf16(g0[0], g0[1]); w.y = pg8::cvt_pk_bf16(g0[2], g0[3]); w.z = pg8::cvt_pk_bf16(g1[0], g1[1]); w.w = pg8::cvt_pk_bf16(g1[2], g1[3]);
                        const int c = 2 * u.pm + bj;
                        bf16_t* dst = GVTF + ((((((size_t)c * 8 + ch) * 4 + cwc) * 2 + cn) * 4 + wc) * 512) + (fq * 16 + cfr) * 8;
                        *(u32x4*)dst = w;
                    }
                }
            float mine = 0.f;
#pragma unroll
            for (int bj = 0; bj < 2; ++bj)
#pragma unroll
                for (int n = 0; n < 2; ++n)
#pragma unroll
                    for (int j = 0; j < 4; ++j) {
                        float s = ss[bj][n][j];
                        s += __builtin_bit_cast(float, __builtin_amdgcn_update_dpp(0, __builtin_bit_cast(int, s), 0x128, 0xf, 0xf, false));
                        s += __builtin_bit_cast(float, __builtin_amdgcn_update_dpp(0, __builtin_bit_cast(int, s), 0x124, 0xf, 0xf, false));
                        s += __builtin_bit_cast(float, __builtin_amdgcn_update_dpp(0, __builtin_bit_cast(int, s), 0x122, 0xf, 0xf, false));
                        s += __builtin_bit_cast(float, __builtin_amdgcn_update_dpp(0, __builtin_bit_cast(int, s), 0x121, 0xf, 0xf, false));
                        if (fr == bj * 8 + n * 4 + j) mine = s;
                    }
            const int tokl = (fr >> 3) * 128 + wc * 32 + 8 * fq + (fr & 7);
            if (wr == 1) xch[tokl] = mine;
            asm volatile("s_waitcnt lgkmcnt(0)" ::: "memory"); __builtin_amdgcn_s_barrier(); asm volatile("" ::: "memory");
            if (wr == 0) unsafeAtomicAdd(vss + u.pm * 256 + tokl, mine + xch[tokl]);
        } else {
            const int h = pn - 4;
            const int row0 = u.pm * 256 + wr * 64 + fr, col0 = h * 128 + wc * 32 + 8 * fq;
#pragma unroll
            for (int ai = 0; ai < 2; ++ai)
#pragma unroll
                for (int m = 0; m < 4; ++m) {
                    bf16_t* rowp = HB + (size_t)(row0 + ai * 128 + m * 16) * DM + col0;
                    const f32x4 r0 = acc[ai][0][m][0] * acc[ai][1][m][0], r1 = acc[ai][0][m][1] * acc[ai][1][m][1];
                    u32x4 w; w.x = pg8::cvt_pk_bf16(r0[0], r0[1]); w.y = pg8::cvt_pk_bf16(r0[2], r0[3]); w.z = pg8::cvt_pk_bf16(r1[0], r1[1]); w.w = pg8::cvt_pk_bf16(r1[2], r1[3]);
                    *(u32x4*)rowp = w;
                }
        }
    }
};
struct EpiG1b {
    static constexpr bool PERM = true, AFTER_DRAIN = false;
    const bf16_t* HB; const bf16_t* GVTF; const bf16_t* WSB; const float* vss; const float* g_v; const float* b_s; const float* conv_w; bf16_t* MIX; float* o_scp; PG8_LAS unsigned char* wfr;
    __device__ __forceinline__ void operator()(const f32x4 (&acc)[2][2][4][2], const pg8::Unit& u, int wr, int wc, int fr, int fq) const {
        const int pn = u.pn, lane = fq * 16 + fr;
        if (pn < 8) {
            const int h = pn;
            {
                const int w8 = wr * 4 + wc, st = (w8 * w8 + 2 * w8 + (w8 & 1)) >> 2;
#pragma unroll
                for (int kk = 0; kk < 4; ++kk) if (kk <= (w8 >> 1))
                    *(PG8_LAS u32x4*)(wfr + (st + kk) * 1024 + lane * 16) = *(const u32x4*)(WSB + (size_t)(h * 128 + 16 * w8 + fr) * 128 + 32 * kk + 8 * fq);
                asm volatile("s_waitcnt lgkmcnt(0)" ::: "memory"); __builtin_amdgcn_s_barrier(); asm volatile("" ::: "memory");
            }
            const int nkw = 2 * wr + 2;
            const int d0 = h * 128 + wc * 32 + 8 * fq;
            const f32x4 gva = *(const f32x4*)(g_v + d0), gvb = *(const f32x4*)(g_v + d0 + 4);
#pragma unroll
            for (int ai = 0; ai < 2; ++ai) {
                const int c = 2 * u.pm + ai, tokc = c * 128;
                float iv[4][8]; bf16x8 Bf[2][4]; f32x4 sa[4], sb[4];
#pragma unroll
                for (int kk = 0; kk < 4; ++kk) {
                    if (kk < nkw) {
                        sa[kk] = *(const f32x4*)(vss + tokc + 32 * kk + 8 * fq); sb[kk] = *(const f32x4*)(vss + tokc + 32 * kk + 8 * fq + 4);
#pragma unroll
                        for (int n = 0; n < 2; ++n) Bf[n][kk] = *(const bf16x8*)(GVTF + ((((((size_t)c * 8 + h) * 4 + wc) * 2 + n) * 4 + kk) * 512) + lane * 8);
                    } else {
                        sa[kk] = (f32x4){0.f, 0.f, 0.f, 0.f}; sb[kk] = sa[kk];
#pragma unroll
                        for (int n = 0; n < 2; ++n) Bf[n][kk] = (bf16x8){0, 0, 0, 0, 0, 0, 0, 0};
                    }
                }
                unsigned pk[4][4];
#pragma unroll
                for (int m = 0; m < 4; ++m) {
                    const f32x4 a0 = pg8::gelu4(acc[ai][0][m][0]) * pg8::silu4(acc[ai][1][m][0]), a1 = pg8::gelu4(acc[ai][0][m][1]) * pg8::silu4(acc[ai][1][m][1]);
                    pk[m][0] = pg8::cvt_pk_bf16(a0[0], a0[1]); pk[m][1] = pg8::cvt_pk_bf16(a0[2], a0[3]); pk[m][2] = pg8::cvt_pk_bf16(a1[0], a1[1]); pk[m][3] = pg8::cvt_pk_bf16(a1[2], a1[3]);
                }
#pragma unroll
                for (int kk = 0; kk < 4; ++kk)
#pragma unroll
                    for (int i = 0; i < 4; ++i) { iv[kk][i] = __builtin_amdgcn_rsqf(sa[kk][i] * (1.f / DM) + EPS); iv[kk][4 + i] = __builtin_amdgcn_rsqf(sb[kk][i] * (1.f / DM) + EPS); }
#pragma unroll
                for (int m = 0; m < 4; ++m) {
                    const int t = 64 * wr + 16 * m + fr, nk = 2 * wr + (m >> 1) + 1;
                    f32x4 c0 = (f32x4){0.f, 0.f, 0.f, 0.f}, c1 = c0;
#pragma unroll
                    for (int kk = 0; kk < 4; ++kk) if (kk < nk) {
                        const u32x4 wraw = *(const PG8_LAS u32x4*)(wfr + ((((4 * wr + m) * (4 * wr + m) + 2 * (4 * wr + m) + (m & 1)) >> 2) + kk) * 1024 + lane * 16);
                        u32x4 p;
#pragma unroll
                        for (int q = 0; q < 4; ++q) p[q] = pg8::cvt_pk_bf16(bf_lo(wraw[q]) * iv[kk][2 * q], bf_hi(wraw[q]) * iv[kk][2 * q + 1]);
                        const bf16x8 Af = __builtin_bit_cast(bf16x8, p);
                        c0 = __builtin_amdgcn_mfma_f32_16x16x32_bf16(Bf[0][kk], Af, c0, 0, 0, 0);
                        c1 = __builtin_amdgcn_mfma_f32_16x16x32_bf16(Bf[1][kk], Af, c1, 0, 0, 0);
                    }
                    const int row = u.pm * 256 + ai * 128 + t; const float bias = b_s[h * 128 + t];
                    u32x4 o;
                    o.x = pg8::cvt_pk_bf16(bf_lo(pk[m][0]) * (gva[0] * c0[0] + bias), bf_hi(pk[m][0]) * (gva[1] * c0[1] + bias));
                    o.y = pg8::cvt_pk_bf16(bf_lo(pk[m][1]) * (gva[2] * c0[2] + bias), bf_hi(pk[m][1]) * (gva[3] * c0[3] + bias));
                    o.z = pg8::cvt_pk_bf16(bf_lo(pk[m][2]) * (gvb[0] * c1[0] + bias), bf_hi(pk[m][2]) * (gvb[1] * c1[1] + bias));
                    o.w = pg8::cvt_pk_bf16(bf_lo(pk[m][3]) * (gvb[2] * c1[2] + bias), bf_hi(pk[m][3]) * (gvb[3] * c1[3] + bias));
                    *(u32x4*)(MIX + (size_t)row * DMIX + d0) = o;
                }
            }
        } else {
            const int h = pn - 8, c0 = h * 128 + wc * 32 + 8 * fq;
            float w0[8], w1[8], w2[8];
#pragma unroll
            for (int i = 0; i < 2; ++i) { const f32x4 a = *(const f32x4*)(conv_w + c0 + 4 * i), b = *(const f32x4*)(conv_w + 1024 + c0 + 4 * i), cc = *(const f32x4*)(conv_w + 2048 + c0 + 4 * i);
#pragma unroll
                for (int j = 0; j < 4; ++j) { w0[4 * i + j] = a[j]; w1[4 * i + j] = b[j]; w2[4 * i + j] = cc[j]; } }
#pragma unroll
            for (int ai = 0; ai < 2; ++ai) {
                const int rowb = u.pm * 256 + ai * 128 + wr * 64;
                u32x4 hprev = (u32x4){0u, 0u, 0u, 0u};
                if (fr >= 14 && ((rowb & (SEQ - 1)) != 0)) hprev = *(const u32x4*)(HB + (size_t)(rowb - 16 + fr) * DM + c0);
#pragma unroll
                for (int m = 0; m < 4; ++m) {
                    const f32x4 q0 = acc[ai][0][m][0] * pg8::silu4(acc[ai][1][m][0]), q1 = acc[ai][0][m][1] * pg8::silu4(acc[ai][1][m][1]);
                    const int row = rowb + m * 16 + fr, t = row & (SEQ - 1);
                    const u32x4 h0 = *(const u32x4*)(HB + (size_t)row * DM + c0);
                    u32x4 hm1, hm2;
#pragma unroll
                    for (int p = 0; p < 4; ++p) {
                        const int y1 = (fr == 15) ? (int)hprev[p] : (int)h0[p];
                        const int z2 = (fr >= 14) ? (int)hprev[p] : (int)h0[p];
                        hm1[p] = (unsigned)__builtin_amdgcn_update_dpp(0, y1, 0x121, 0xf, 0xf, false);
                        hm2[p] = (unsigned)__builtin_amdgcn_update_dpp(0, z2, 0x122, 0xf, 0xf, false);
                    }
                    float cv[8];
#pragma unroll
                    for (int p = 0; p < 4; ++p) {
                        cv[2 * p] = w0[2 * p] * bf_lo(hm2[p]) + w1[2 * p] * bf_lo(hm1[p]) + w2[2 * p] * bf_lo(h0[p]);
                        cv[2 * p + 1] = w0[2 * p + 1] * bf_hi(hm2[p]) + w1[2 * p + 1] * bf_hi(hm1[p]) + w2[2 * p + 1] * bf_hi(h0[p]);
                    }
                    u32x4 o; o.x = pg8::cvt_pk_bf16(q0[0] * cv[0], q0[1] * cv[1]); o.y = pg8::cvt_pk_bf16(q0[2] * cv[2], q0[3] * cv[3]); o.z = pg8::cvt_pk_bf16(q1[0] * cv[4], q1[1] * cv[5]); o.w = pg8::cvt_pk_bf16(q1[2] * cv[6], q1[3] * cv[7]);
                    *(u32x4*)(MIX + (size_t)row * DMIX + DM + c0) = o;
                    if (t >= SEQ - 2) {
                        float* dst = o_scp + ((size_t)(row / SEQ) * 2 + (t - (SEQ - 2))) * DM + c0;
                        *(f32x4*)dst = (f32x4){bf_lo(h0[0]), bf_hi(h0[0]), bf_lo(h0[1]), bf_hi(h0[1])}; *(f32x4*)(dst + 4) = (f32x4){bf_lo(h0[2]), bf_hi(h0[2]), bf_lo(h0[3]), bf_hi(h0[3])};
                    }
                    hprev = h0;
                }
            }
        }
    }
};
struct EpiG2 {
    static constexpr bool PERM = false, AFTER_DRAIN = false;
    const float* x; float* out; float* yss;
    __device__ __forceinline__ void operator()(const f32x4 (&acc)[2][2][4][2], const pg8::Unit& u, int wr, int wc, int fr, int fq) const {
        const int row0 = u.pm * 256 + wr * 64 + fr, col0 = u.pn * 256 + wc * 32 + 4 * fq;
#pragma unroll
        for (int ai = 0; ai < 2; ++ai)
#pragma unroll
            for (int m = 0; m < 4; ++m) {
                const int row = row0 + ai * 128 + m * 16; const size_t off = (size_t)row * DM + col0; float s = 0.f;
#pragma unroll
                for (int bj = 0; bj < 2; ++bj)
#pragma unroll
                    for (int n = 0; n < 2; ++n) { const f32x4 xv = *(const f32x4*)(x + off + bj * 128 + n * 16); const f32x4 y = xv + acc[ai][bj][m][n];
                        *(f32x4*)(out + off + bj * 128 + n * 16) = y; s += (y[0] * y[0] + y[1] * y[1]) + (y[2] * y[2] + y[3] * y[3]); }
                s += __shfl_xor(s, 16); s += __shfl_xor(s, 32);
                if (fq == 0) unsafeAtomicAdd(yss + row, s);
            }
    }
};

__device__ __forceinline__ void spin_until(unsigned* p, unsigned want) {
    unsigned sp = 0u;
    while (__hip_atomic_load(p, __ATOMIC_RELAXED, __HIP_MEMORY_SCOPE_AGENT) < want) { __builtin_amdgcn_s_sleep(1); if (++sp > (1u << 22)) break; }
}
struct EpiG2f {
    static constexpr bool PERM = false, AFTER_DRAIN = true;
    const float* x; float* out; float* yss; unsigned* cnt; const float* gfin;
    __device__ __forceinline__ void operator()(const f32x4 (&acc)[2][2][4][2], const pg8::Unit& u, int wr, int wc, int fr, int fq) const {}
    __device__ __forceinline__ void fused(f32x4 (&acc)[2][2][4][2], const pg8::Unit& u, int wr, int wc, int fr, int fq, PG8_LAS unsigned char* lds) const {
        const int row0 = u.pm * 256 + wr * 64 + fr, col0 = u.pn * 256 + wc * 32 + 4 * fq;
        PG8_LAS float* part = (PG8_LAS float*)lds;
#pragma unroll
        for (int ai = 0; ai < 2; ++ai)
#pragma unroll
            for (int m = 0; m < 4; ++m) {
                const int row = row0 + ai * 128 + m * 16; const size_t off = (size_t)row * DM + col0; float s = 0.f;
#pragma unroll
                for (int bj = 0; bj < 2; ++bj)
#pragma unroll
                    for (int n = 0; n < 2; ++n) { const f32x4 xv = __builtin_nontemporal_load((const f32x4*)(x + off + bj * 128 + n * 16)); const f32x4 y = xv + acc[ai][bj][m][n];
                        acc[ai][bj][m][n] = y; s += (y[0] * y[0] + y[1] * y[1]) + (y[2] * y[2] + y[3] * y[3]); }
                s += __shfl_xor(s, 16); s += __shfl_xor(s, 32);
                if (fq == 0) part[wc * 256 + ai * 128 + wr * 64 + m * 16 + fr] = s;
                if (m == 3) asm volatile("" ::: "memory");
            }
        asm volatile("s_waitcnt lgkmcnt(0)" ::: "memory"); __builtin_amdgcn_s_barrier(); asm volatile("" ::: "memory");
        const int tid_ = threadIdx.x;
        if (tid_ < 256) {
            unsafeAtomicAdd(yss + u.pm * 256 + tid_, (part[tid_] + part[256 + tid_]) + (part[512 + tid_] + part[768 + tid_]));
            asm volatile("s_waitcnt vmcnt(0)" ::: "memory");
            if ((tid_ & 63) == 0) __hip_atomic_fetch_add(cnt + 64 * u.pm, 1u, __ATOMIC_RELAXED, __HIP_MEMORY_SCOPE_AGENT);
        }
        f32x4 gf[2][2];
#pragma unroll
        for (int bj = 0; bj < 2; ++bj)
#pragma unroll
            for (int n = 0; n < 2; ++n) gf[bj][n] = *(const f32x4*)(gfin + col0 + bj * 128 + n * 16);
        spin_until(cnt + 64 * u.pm, 16u);
#pragma unroll
        for (int ai = 0; ai < 2; ++ai)
#pragma unroll
            for (int m = 0; m < 4; ++m) {
                const int row = row0 + ai * 128 + m * 16; const size_t off = (size_t)row * DM + col0;
                const float ss = __hip_atomic_load(yss + row, __ATOMIC_RELAXED, __HIP_MEMORY_SCOPE_AGENT);
                const float inv = __builtin_amdgcn_rsqf(ss * (1.f / DM) + EPS);
#pragma unroll
                for (int bj = 0; bj < 2; ++bj)
#pragma unroll
                    for (int n = 0; n < 2; ++n) __builtin_nontemporal_store(acc[ai][bj][m][n] * inv * gf[bj][n], (f32x4*)(out + off + bj * 128 + n * 16));
            }
    }
};

struct Args { const float* in[11]; float* out; unsigned char* ws; int ph_lo, ph_hi; };

__device__ __forceinline__ int perm_row(int n) {
    const int sec = n >> 10, r = n & 1023, h = r >> 7, j = r & 127;
    switch (sec) {
        case 1: return r;
        case 3: return (4 + h) * 256 + j;
        case 5: return (4 + h) * 256 + 128 + j;
        case 0: return (12 + h) * 256 + j;
        case 2: return (12 + h) * 256 + 128 + j;
        case 4: return (20 + h) * 256 + j;
        default: return (20 + h) * 256 + 128 + j;
    }
}
__device__ __forceinline__ void p0_load_item(const float* __restrict__ W, int N, int item, int lane, f32x4 (&v)[8]) {
    const int nblk = N / 32, kb = item / nblk, nb = item % nblk;
    const float* p = W + (size_t)(64 * kb + 8 * (lane >> 3)) * N + 32 * nb + 4 * (lane & 7);
#pragma unroll
    for (int i = 0; i < 8; ++i) v[i] = __builtin_nontemporal_load((const f32x4*)(p + (size_t)i * N));
}
__device__ __forceinline__ void p0_store_item(bf16_t* __restrict__ WT, int K, int N, bool perm, int item, int lane, const f32x4 (&v)[8]) {
    const int nblk = N / 32, kb = item / nblk, nb = item % nblk, n0 = 32 * nb;
    const int r0 = perm ? perm_row(n0) : n0;
    bf16_t* q = WT + (size_t)(r0 + 4 * (lane & 7)) * K + 64 * kb + 8 * (lane >> 3);
#pragma unroll
    for (int j = 0; j < 4; ++j) {
        u32x4 o; o.x = pg8::cvt_pk_bf16(v[0][j], v[1][j]); o.y = pg8::cvt_pk_bf16(v[2][j], v[3][j]); o.z = pg8::cvt_pk_bf16(v[4][j], v[5][j]); o.w = pg8::cvt_pk_bf16(v[6][j], v[7][j]);
        st16_wt(q + (size_t)j * K, o);
    }
}

__global__ void __launch_bounds__(NWAVES * 64, 2) fwd_kernel(Args args) {
    extern __shared__ __attribute__((aligned(16))) unsigned char lds_raw[];
    LAS unsigned char* lds = (LAS unsigned char*)lds_raw;
    cg::grid_group grid = cg::this_grid();
    const int tid = threadIdx.x, lane = tid & 63, wave = __builtin_amdgcn_readfirstlane(tid >> 6);
    const int G = gridDim.x, bx = blockIdx.x;
    const int gw = bx * NWAVES + wave, NGW = G * NWAVES;
    const int fr = lane & 15, fq = lane >> 4;
    unsigned char* ws = args.ws;
    const float* x_prompt = args.in[0]; const float* x_sample = args.in[1]; const float* state_conv = args.in[2]; const float* g_norm = args.in[3];
    const float* w_in = args.in[4]; const float* w_s = args.in[5]; const float* b_s = args.in[6]; const float* g_v = args.in[7];
    const float* conv_w = args.in[8]; const float* w_out = args.in[9]; const float* g_final = args.in[10];
    float* out = args.out;
    float* vss = (float*)(ws + WS_VSS); float* yss = (float*)(ws + WS_YSS);
    bf16_t* BT1 = (bf16_t*)(ws + WS_BT1); bf16_t* BT2 = (bf16_t*)(ws + WS_BT2); bf16_t* WSB = (bf16_t*)(ws + WS_WSB); bf16_t* XN = (bf16_t*)(ws + WS_XN);
    bf16_t* PAS = (bf16_t*)(ws + WS_PAS); bf16_t* HBS = (bf16_t*)(ws + WS_HBS); bf16_t* QBS = (bf16_t*)(ws + WS_QBS); bf16_t* GVS = (bf16_t*)(ws + WS_GVS);
    bf16_t* HB = (bf16_t*)(ws + WS_HB); bf16_t* GVTF = (bf16_t*)(ws + WS_GVTF); bf16_t* MIX = (bf16_t*)(ws + WS_MIX);
    float* y_all = out;
    float* o_scp = out + (size_t)NTOK * DM;
    float* o_scs = o_scp + 8 * 2 * 1024;
    float* o_svs = o_scs + 128 * 2 * 1024;
    const int lo = args.ph_lo, hi = args.ph_hi;
    volatile LAS unsigned* MISC = (volatile LAS unsigned*)(lds + 131072);
    if (tid < 16) MISC[tid] = 0u;
    __syncthreads();
    XcdBarrier xbar = xcd_barrier_post((unsigned*)(ws + WS_BAR), MISC + 8);
    if (lo > 1000) grid.sync();
#define IN(k) (lo <= (k) && (k) < hi)
#define BOTH(k) (IN(k) && IN((k) + 1))
#define GSYNC() do { xcd_barrier(xbar); } while (0)

    if (IN(0)) {
        constexpr int I_1 = (DM / 64) * (DIN / 32), I_2 = (DMIX / 64) * (DM / 32);
        for (int it = gw; it < I_1 + I_2; it += 2 * NGW) {
            const int it2 = it + NGW; const bool has2 = it2 < I_1 + I_2;
            f32x4 va[8], vb[8];
            if (it < I_1) p0_load_item(w_in, DIN, it, lane, va); else p0_load_item(w_out, DM, it - I_1, lane, va);
            if (has2) { if (it2 < I_1) p0_load_item(w_in, DIN, it2, lane, vb); else p0_load_item(w_out, DM, it2 - I_1, lane, vb); }
            if (it < I_1) p0_store_item(BT1, DM, DIN, true, it, lane, va); else p0_store_item(BT2, DMIX, DM, false, it - I_1, lane, va);
            if (has2) { if (it2 < I_1) p0_store_item(BT1, DM, DIN, true, it2, lane, vb); else p0_store_item(BT2, DMIX, DM, false, it2 - I_1, lane, vb); }
        }
        f32x4 gn[4];
#pragma unroll
        for (int j = 0; j < 4; ++j) gn[j] = *((const f32x4*)g_norm + lane + 64 * j);
        for (int m0 = gw; m0 < NTOK; m0 += 4 * NGW) {
            f32x4 v[4][4]; float s[4];
#pragma unroll
            for (int r = 0; r < 4; ++r) {
                const int m = m0 + r * NGW; s[r] = 0.f;
                if (m < NTOK) {
                    const float* xrow = m < NTOK_P ? x_prompt + (size_t)m * DM : x_sample + (size_t)(m - NTOK_P) * DM;
                    const f32x4* xr = (const f32x4*)xrow + lane;
#pragma unroll
                    for (int j = 0; j < 4; ++j) v[r][j] = xr[64 * j];
                } else {
#pragma unroll
                    for (int j = 0; j < 4; ++j) v[r][j] = (f32x4){0.f, 0.f, 0.f, 0.f};
                }
            }
#pragma unroll
            for (int r = 0; r < 4; ++r) {
#pragma unroll
                for (int j = 0; j < 4; ++j) s[r] += (v[r][j][0] * v[r][j][0] + v[r][j][1] * v[r][j][1]) + (v[r][j][2] * v[r][j][2] + v[r][j][3] * v[r][j][3]);
                s[r] = wave_sum(s[r]);
            }
#pragma unroll
            for (int r = 0; r < 4; ++r) {
                const int m = m0 + r * NGW;
                if (m < NTOK) {
                    unsigned long long* o8 = (unsigned long long*)(XN + (size_t)m * DM) + lane;
                    const float inv = __builtin_amdgcn_rsqf(s[r] * (1.f / DM) + EPS);
#pragma unroll
                    for (int j = 0; j < 4; ++j) { const f32x4 t = v[r][j] * inv * gn[j];
                        st8_wt(o8 + 64 * j, (unsigned long long)pg8::cvt_pk_bf16(t[0], t[1]) | ((unsigned long long)pg8::cvt_pk_bf16(t[2], t[3]) << 32)); }
                }
            }
        }
        for (int i = bx * (NWAVES * 64) + tid; i < 2 * MPAD; i += G * NWAVES * 64) vss[i] = 0.f;
        for (int i = bx * (NWAVES * 64) + tid; i < 8 * 128 * 128 / 8; i += G * NWAVES * 64) {
            const int e0 = i * 8, t = (e0 >> 7) & 127, s0 = e0 & 127;
            const f32x4 a = *(const f32x4*)(w_s + e0), b = *(const f32x4*)(w_s + e0 + 4);
            u32x4 p; p.x = pg8::cvt_pk_bf16(s0 <= t ? a[0] : 0.f, s0 + 1 <= t ? a[1] : 0.f); p.y = pg8::cvt_pk_bf16(s0 + 2 <= t ? a[2] : 0.f, s0 + 3 <= t ? a[3] : 0.f);
            p.z = pg8::cvt_pk_bf16(s0 + 4 <= t ? b[0] : 0.f, s0 + 5 <= t ? b[1] : 0.f); p.w = pg8::cvt_pk_bf16(s0 + 6 <= t ? b[2] : 0.f, s0 + 7 <= t ? b[3] : 0.f);
            *(u32x4*)(WSB + e0) = p;
        }
        if (BOTH(0)) GSYNC();
    }

    if (IN(1)) {
        {
            pg8::Gemm g{XN, BT1, NTOK_P, N1A, DM}; pg8::OrderG1 S; S.init(NTOK_P, N1A, G, bx);
            EpiG1a E{HB, GVTF, vss, (LAS float*)(lds + 131072 + 256)};
            pg8::gemm_phase<EpiG1a, pg8::OrderG1, true, true>(lds, g, S, E);
        }
        const bool shared_tail = (G >= 224);
        if (shared_tail && bx < 224) {
            const int T = bx >> 3, ct = bx & 7;
#pragma unroll
            for (int i = 0; i < 8; ++i) { const int p = tid + 512 * i, row = p >> 7, c16 = p & 127;
                const u32x4 v = *(const u32x4*)(BT1 + (size_t)(T * 256 + (row >> 4) * 128 + 16 * ct + (row & 15)) * DM + c16 * 8);
                *(LAS u32x4*)(lds + row * 2064 + c16 * 16) = v; }
            __syncthreads();
        }
        for (int t = shared_tail ? (bx < 224 ? bx * 8 + wave : 8 * 28 * 8) : wave * G + bx; t < 8 * 28 * 8; t += shared_tail ? 8 * 28 * 8 : NGW) {
            const int tb = t & 7, ct = (t >> 3) & 7, T = t >> 6;
            const bf16_t* ap = XN + (size_t)(NTOK_P + 16 * tb + fr) * DM + 8 * fq;
            f32x4 a0 = (f32x4){0.f, 0.f, 0.f, 0.f}, a1 = a0;
            if (shared_tail) {
                const LAS unsigned char* lb0 = lds + fr * 2064 + fq * 16; const LAS unsigned char* lb1 = lb0 + 16 * 2064;
#pragma unroll 16
                for (int kk = 0; kk < DM / 32; ++kk) {
                    const bf16x8 af = *(const bf16x8*)(ap + 32 * kk);
                    a0 = __builtin_amdgcn_mfma_f32_16x16x32_bf16(*(const LAS bf16x8*)(lb0 + 64 * kk), af, a0, 0, 0, 0);
                    a1 = __builtin_amdgcn_mfma_f32_16x16x32_bf16(*(const LAS bf16x8*)(lb1 + 64 * kk), af, a1, 0, 0, 0);
                }
            } else {
                const bf16_t* bp0 = BT1 + (size_t)(T * 256 + 16 * ct + fr) * DM + 8 * fq; const bf16_t* bp1 = bp0 + (size_t)128 * DM;
#pragma unroll 16
                for (int kk = 0; kk < DM / 32; ++kk) {
                    const bf16x8 af = *(const bf16x8*)(ap + 32 * kk);
                    a0 = __builtin_amdgcn_mfma_f32_16x16x32_bf16(*(const bf16x8*)(bp0 + 32 * kk), af, a0, 0, 0, 0);
                    a1 = __builtin_amdgcn_mfma_f32_16x16x32_bf16(*(const bf16x8*)(bp1 + 32 * kk), af, a1, 0, 0, 0);
                }
            }
            const int srow = 16 * tb + fr, cl = 16 * ct + 4 * fq;
            if (T < 4) {
                const f32x4 g0 = pg8::gelu4(a0), g1 = pg8::gelu4(a1);
                u32x2 w0; w0.x = pg8::cvt_pk_bf16(g0[0], g0[1]); w0.y = pg8::cvt_pk_bf16(g0[2], g0[3]);
                u32x2 w1; w1.x = pg8::cvt_pk_bf16(g1[0], g1[1]); w1.y = pg8::cvt_pk_bf16(g1[2], g1[3]);
                *(u32x2*)(GVS + (size_t)srow * DM + T * 256 + cl) = w0; *(u32x2*)(GVS + (size_t)srow * DM + T * 256 + 128 + cl) = w1;
                float s = (g0[0] * g0[0] + g0[1] * g0[1]) + (g0[2] * g0[2] + g0[3] * g0[3]) + (g1[0] * g1[0] + g1[1] * g1[1]) + (g1[2] * g1[2] + g1[3] * g1[3]);
                s += __shfl_xor(s, 16); s += __shfl_xor(s, 32);
                if (fq == 0) unsafeAtomicAdd(vss + NTOK_P + srow, s);
            } else {
                const int mode = T < 12 ? 1 : (T < 20 ? 0 : 2), h = T < 12 ? T - 4 : (T < 20 ? T - 12 : T - 20);
                f32x4 r;
                if (mode == 1) r = a0 * a1; else if (mode == 0) r = pg8::gelu4(a0) * pg8::silu4(a1); else r = a0 * pg8::silu4(a1);
                bf16_t* O = (bf16_t*)(ws + (mode == 1 ? WS_HBS : (mode == 0 ? WS_PAS : WS_QBS)));
                u32x2 w; w.x = pg8::cvt_pk_bf16(r[0], r[1]); w.y = pg8::cvt_pk_bf16(r[2], r[3]);
                *(u32x2*)(O + (size_t)srow * DM + h * 128 + cl) = w;
            }
        }
        if (BOTH(1)) GSYNC();
    }

    if (IN(2)) {
        for (int item = bx * (NWAVES * 64) + tid; item < NSMP * 256; item += G * NWAVES * 64) {
            const int b = item >> 8, cg8 = item & 255, row = NTOK_P + b;
            if (cg8 < 128) {
                const int c0 = cg8 * 8, h = c0 >> 7;
                const float inv = __builtin_amdgcn_rsqf(vss[row] * (1.f / DM) + EPS), w00 = w_s[(size_t)h * 128 * 128], b0 = b_s[h * 128];
                const u32x4 pa = *(const u32x4*)(PAS + (size_t)b * DM + c0), gv = *(const u32x4*)(GVS + (size_t)b * DM + c0);
                const f32x4 ga = *(const f32x4*)(g_v + c0), gb = *(const f32x4*)(g_v + c0 + 4);
                float vn[8], o[8];
#pragma unroll
                for (int p = 0; p < 4; ++p) { vn[2 * p] = bf_lo(gv[p]) * inv; vn[2 * p + 1] = bf_hi(gv[p]) * inv; }
#pragma unroll
                for (int i = 0; i < 4; ++i) { vn[i] *= ga[i]; vn[4 + i] *= gb[i]; }
#pragma unroll
                for (int p = 0; p < 4; ++p) { o[2 * p] = bf_lo(pa[p]) * (w00 * vn[2 * p] + b0); o[2 * p + 1] = bf_hi(pa[p]) * (w00 * vn[2 * p + 1] + b0); }
                u32x4 ov; ov.x = pg8::cvt_pk_bf16(o[0], o[1]); ov.y = pg8::cvt_pk_bf16(o[2], o[3]); ov.z = pg8::cvt_pk_bf16(o[4], o[5]); ov.w = pg8::cvt_pk_bf16(o[6], o[7]);
                *(u32x4*)(MIX + (size_t)row * DMIX + c0) = ov;
                float* dv = o_svs + (size_t)b * DM + c0;
                *(f32x4*)dv = (f32x4){vn[0], vn[1], vn[2], vn[3]}; *(f32x4*)(dv + 4) = (f32x4){vn[4], vn[5], vn[6], vn[7]};
            } else {
                const int c0 = (cg8 - 128) * 8;
                const u32x4 h0 = *(const u32x4*)(HBS + (size_t)b * DM + c0), q = *(const u32x4*)(QBS + (size_t)b * DM + c0);
                const float* st0 = state_conv + ((size_t)b * 2 + 0) * DM + c0; const float* st1 = state_conv + ((size_t)b * 2 + 1) * DM + c0;
                float s0[8], s1[8], hv[8], qv[8], o[8];
#pragma unroll
                for (int i = 0; i < 2; ++i) { const f32x4 a = *(const f32x4*)(st0 + 4 * i), bb = *(const f32x4*)(st1 + 4 * i);
#pragma unroll
                    for (int j = 0; j < 4; ++j) { s0[4 * i + j] = a[j]; s1[4 * i + j] = bb[j]; } }
#pragma unroll
                for (int p = 0; p < 4; ++p) { hv[2 * p] = bf_lo(h0[p]); hv[2 * p + 1] = bf_hi(h0[p]); qv[2 * p] = bf_lo(q[p]); qv[2 * p + 1] = bf_hi(q[p]); }
#pragma unroll
                for (int i = 0; i < 8; ++i) o[i] = qv[i] * (conv_w[c0 + i] * s0[i] + conv_w[1024 + c0 + i] * s1[i] + conv_w[2048 + c0 + i] * hv[i]);
                u32x4 ov; ov.x = pg8::cvt_pk_bf16(o[0], o[1]); ov.y = pg8::cvt_pk_bf16(o[2], o[3]); ov.z = pg8::cvt_pk_bf16(o[4], o[5]); ov.w = pg8::cvt_pk_bf16(o[6], o[7]);
                *(u32x4*)(MIX + (size_t)row * DMIX + DM + c0) = ov;
                float* d0 = o_scs + ((size_t)b * 2 + 0) * DM + c0; float* d1 = d0 + DM;
                *(f32x4*)d0 = (f32x4){s1[0], s1[1], s1[2], s1[3]}; *(f32x4*)(d0 + 4) = (f32x4){s1[4], s1[5], s1[6], s1[7]};
                *(f32x4*)d1 = (f32x4){hv[0], hv[1], hv[2], hv[3]}; *(f32x4*)(d1 + 4) = (f32x4){hv[4], hv[5], hv[6], hv[7]};
            }
        }
        {
            pg8::Gemm g{XN, BT1 + (size_t)N1A * DM, NTOK_P, N1B, DM}; pg8::StaticOrder S; S.init(NTOK_P, N1B, G, bx);
            EpiG1b E{HB, GVTF, WSB, vss, g_v, b_s, conv_w, MIX, o_scp, lds + WFR_OFF};
            pg8::gemm_phase<EpiG1b, pg8::StaticOrder, true, true>(lds, g, S, E);
        }
        if (BOTH(2)) GSYNC();
    }

    const bool fusedn = (G == 256);
    if (IN(3)) {
        unsigned* cw = (unsigned*)(ws + WS_BAR);
        if (fusedn) {
            pg8::Gemm g{MIX, BT2, NTOK_P, DM, DMIX}; pg8::StaticOrder S; S.init(NTOK_P, DM, G, bx);
            EpiG2f E{x_prompt, y_all, yss, cw + 4096, g_final};
            pg8::gemm_phase<EpiG2f, pg8::StaticOrder, false, true>(lds, g, S, E);
        } else {
            pg8::Gemm g{MIX, BT2, NTOK_P, DM, DMIX}; pg8::StaticOrder S; S.init(NTOK_P, DM, G, bx);
            EpiG2 E{x_prompt, y_all, yss};
            pg8::gemm_phase<EpiG2, pg8::StaticOrder, true, true>(lds, g, S, E);
        }
        if (fusedn) {
            const int t = bx * 2 + (wave >> 2), q = wave & 3, tb = t & 7, nb = t >> 3;
            const bf16_t* ap = MIX + (size_t)(NTOK_P + 16 * tb + fr) * DMIX + q * 512 + 8 * fq; const bf16_t* bp = BT2 + (size_t)(16 * nb + fr) * DMIX + q * 512 + 8 * fq;
            bf16x8 af[16], bf[16];
#pragma unroll
            for (int kk = 0; kk < 16; ++kk) { af[kk] = *(const bf16x8*)(ap + 32 * kk); bf[kk] = *(const bf16x8*)(bp + 32 * kk); }
            const int srow = 16 * tb + fr, col = 16 * nb + 4 * fq;
            const f32x4 xs = *(const f32x4*)(x_sample + (size_t)srow * DM + col), gf = *(const f32x4*)(g_final + col);
            f32x4 a0 = (f32x4){0.f, 0.f, 0.f, 0.f}, a1 = a0;
#pragma unroll
            for (int kk = 0; kk < 16; kk += 2) { a0 = __builtin_amdgcn_mfma_f32_16x16x32_bf16(bf[kk], af[kk], a0, 0, 0, 0); a1 = __builtin_amdgcn_mfma_f32_16x16x32_bf16(bf[kk + 1], af[kk + 1], a1, 0, 0, 0); }
            LAS f32x4* part = (LAS f32x4*)lds;
            part[wave * 64 + lane] = a0 + a1;
            __syncthreads();
            if (q == 0) {
                f32x4 y = xs + part[wave * 64 + lane] + part[(wave + 1) * 64 + lane] + part[(wave + 2) * 64 + lane] + part[(wave + 3) * 64 + lane];
                float s = (y[0] * y[0] + y[1] * y[1]) + (y[2] * y[2] + y[3] * y[3]);
                s += __shfl_xor(s, 16); s += __shfl_xor(s, 32);
                if (fq == 0) unsafeAtomicAdd(yss + NTOK_P + srow, s);
                asm volatile("s_waitcnt vmcnt(0)" ::: "memory");
                if (lane == 0) __hip_atomic_fetch_add(cw + 8192 + 64 * tb, 1u, __ATOMIC_RELAXED, __HIP_MEMORY_SCOPE_AGENT);
                spin_until(cw + 8192 + 64 * tb, 64u);
                const float ss = __hip_atomic_load(yss + NTOK_P + srow, __ATOMIC_RELAXED, __HIP_MEMORY_SCOPE_AGENT);
                y = y * __builtin_amdgcn_rsqf(ss * (1.f / DM) + EPS) * gf;
                *(f32x4*)(y_all + (size_t)(NTOK_P + srow) * DM + col) = y;
            }
        } else
        for (int t = wave * G + bx; t < (NSMP / 16) * (DM / 16); t += NGW) {
            const int tb = t & 7, nb = t >> 3;
            const bf16_t* ap = MIX + (size_t)(NTOK_P + 16 * tb + fr) * DMIX + 8 * fq; const bf16_t* bp = BT2 + (size_t)(16 * nb + fr) * DMIX + 8 * fq;
            f32x4 a0 = (f32x4){0.f, 0.f, 0.f, 0.f}, a1 = a0;
#pragma unroll 8
            for (int kk = 0; kk < DMIX / 32; kk += 2) {
                a0 = __builtin_amdgcn_mfma_f32_16x16x32_bf16(*(const bf16x8*)(bp + 32 * kk), *(const bf16x8*)(ap + 32 * kk), a0, 0, 0, 0);
                a1 = __builtin_amdgcn_mfma_f32_16x16x32_bf16(*(const bf16x8*)(bp + 32 * kk + 32), *(const bf16x8*)(ap + 32 * kk + 32), a1, 0, 0, 0);
            }
            const int srow = 16 * tb + fr, col = 16 * nb + 4 * fq;
            f32x4 y = *(const f32x4*)(x_sample + (size_t)srow * DM + col) + a0 + a1;
            float s = (y[0] * y[0] + y[1] * y[1]) + (y[2] * y[2] + y[3] * y[3]);
            s += __shfl_xor(s, 16); s += __shfl_xor(s, 32);
            if (fq == 0) unsafeAtomicAdd(yss + NTOK_P + srow, s);
            if (fusedn) {
                asm volatile("s_waitcnt vmcnt(0)" ::: "memory");
                if (lane == 0) __hip_atomic_fetch_add(cw + 8192 + 64 * tb, 1u, __ATOMIC_RELAXED, __HIP_MEMORY_SCOPE_AGENT);
                const f32x4 gf = *(const f32x4*)(g_final + col);
                spin_until(cw + 8192 + 64 * tb, 64u);
                const float ss = __hip_atomic_load(yss + NTOK_P + srow, __ATOMIC_RELAXED, __HIP_MEMORY_SCOPE_AGENT);
                y = y * __builtin_amdgcn_rsqf(ss * (1.f / DM) + EPS) * gf;
            }
            *(f32x4*)(y_all + (size_t)(NTOK_P + srow) * DM + col) = y;
        }
        if (BOTH(3) && !fusedn) GSYNC();
    }

    if (IN(4) && !fusedn) {
        f32x4 gf[4];
#pragma unroll
        for (int j = 0; j < 4; ++j) gf[j] = *((const f32x4*)g_final + lane + 64 * j);
        for (int m = gw; m < NTOK; m += NGW) {
            const float inv = 1.0f / sqrtf(yss[m] * (1.f / DM) + EPS);
            f32x4* yr = (f32x4*)(y_all + (size_t)m * DM) + lane;
#pragma unroll
            for (int j = 0; j < 4; ++j) yr[64 * j] = yr[64 * j] * inv * gf[j];
        }
    }
#undef IN
#undef BOTH
#undef GSYNC
}

extern "C" void kernel_launch(void* const* d_in, const int* in_sizes, int n_in, void* d_out, int out_size, void* d_ws, size_t ws_size, hipStream_t stream) {
    static int grid = 0;
    if (grid == 0) {
        int dev = 0, cus = 0, per_cu = 0;
        if (hipGetDevice(&dev) != hipSuccess || hipDeviceGetAttribute(&cus, hipDeviceAttributeMultiprocessorCount, dev) != hipSuccess) { fprintf(stderr, "kernel_launch: device query failed\n"); grid = -1; return; }
        if (hipFuncSetAttribute((const void*)fwd_kernel, hipFuncAttributeMaxDynamicSharedMemorySize, LDS_BYTES) != hipSuccess) { fprintf(stderr, "kernel_launch: hipFuncSetAttribute failed\n"); grid = -1; return; }
        if (hipOccupancyMaxActiveBlocksPerMultiprocessor(&per_cu, (const void*)fwd_kernel, NWAVES * 64, LDS_BYTES) != hipSuccess || per_cu < 1) { fprintf(stderr, "kernel_launch: occupancy query says %d blocks per CU\n", per_cu); (void)hipGetLastError(); grid = -1; return; }
        grid = cus;
        if (n_in != 11 || ws_size < WS_END) { fprintf(stderr, "kernel_launch: unexpected inputs (n_in %d, ws %zu)\n", n_in, ws_size); grid = -1; return; }
    }
    if (grid < 0) return;
    if (hipMemsetAsync((char*)d_ws + WS_BAR, 0, BAR_BYTES, stream) != hipSuccess) { fprintf(stderr, "kernel_launch: memset failed\n"); return; }
    Args a{};
    for (int i = 0; i < 11; ++i) a.in[i] = (const float*)d_in[i];
    a.out = (float*)d_out; a.ws = (unsigned char*)d_ws;
#if MK_N_LAUNCHES == 1
    a.ph_lo = 0; a.ph_hi = 5;
    void* kargs[] = {&a};
    hipError_t e = hipLaunchCooperativeKernel((const void*)fwd_kernel, dim3(grid), dim3(NWAVES * 64), kargs, LDS_BYTES, stream);
    if (e != hipSuccess) fprintf(stderr, "kernel_launch: cooperative launch failed: %s (grid %d)\n", hipGetErrorString(e), grid);
#else
    for (int p = 0; p < 5; ++p) { a.ph_lo = p; a.ph_hi = p + 1; hipLaunchKernelGGL(fwd_kernel, dim3(grid), dim3(NWAVES * 64), LDS_BYTES, stream, a); }
#endif
}
```

```cpp
#include <hip/hip_runtime.h>
#include <hip/hip_cooperative_groups.h>
#include <cstdio>
#include <cstdint>
namespace cg = cooperative_groups;

#ifndef PROBE_SYNC2
#define PROBE_SYNC2 0
#endif
#ifndef PROBE_P2X2
#define PROBE_P2X2 0
#endif
#ifndef MK_N_LAUNCHES
#define MK_N_LAUNCHES 1
#endif

namespace pg8 {
#define PG8_LAS __attribute__((address_space(3)))
typedef unsigned short bf16_t;
typedef short bf16x8 __attribute__((ext_vector_type(8)));
typedef float f32x4 __attribute__((ext_vector_type(4)));
typedef float f32x2 __attribute__((ext_vector_type(2)));
typedef unsigned u32x4 __attribute__((ext_vector_type(4)));
typedef unsigned u32x2 __attribute__((ext_vector_type(2)));
constexpr int BM = 256, BK = 64, HALF = 128, HTB = HALF * BK * 2, STAGE_BYTES = 8 * HTB, NXCD = 8, WGM = 8;

__host__ __device__ __forceinline__ int lds_byte(int r, int c) { const int st = (r >> 4) * 2 + (c >> 5), rr = r & 15, cc = c & 31, ob = rr * 64 + cc * 2; return st * 1024 + (ob ^ (((ob >> 9) & 1) << 5)); }
__host__ __device__ __forceinline__ void stage_rc(int b, int& R, int& C) { const int st = b / 1024, sb = b % 1024, swz = sb ^ (((sb >> 9) & 1) << 5); R = (st >> 1) * 16 + swz / 64; C = (st & 1) * 32 + (swz % 64) / 2; }
__host__ __device__ __forceinline__ int perm32(int rho) { const int n = rho >> 4, i = rho & 15; return 8 * (i >> 2) + 4 * n + (i & 3); }

struct Unit { int pm, pn; };
struct Gemm { const bf16_t* A; const bf16_t* Bt; int M, N, K; };

struct StaticOrder {
    int nM, nN, nwg, G, c;
    __host__ __device__ void init(int M, int N, int G_, int c_) { nM = M / BM; nN = N / BM; nwg = nM * nN; G = G_; c = c_; }
    __host__ __device__ bool next(int i, Unit& u) const {
        const long L = (long)i * G + c; if (L >= nwg) return false;
        int wgid = (int)L; { const int q = nwg / NXCD, r = nwg % NXCD, xcd = wgid % NXCD, off = wgid / NXCD; wgid = (xcd < r ? xcd * (q + 1) : r * (q + 1) + (xcd - r) * q) + off; }
        const int nig = WGM * nN, gid = wgid / nig, fm = gid * WGM, gsz = (nM - fm) < WGM ? (nM - fm) : WGM;
        u.pm = fm + ((wgid % nig) % gsz); u.pn = (wgid % nig) / gsz; return true;
    }
    __device__ __forceinline__ void ptrs(const Gemm& g, const Unit& u, size_t tstep, const char*& a, const char*& b) const {
        a = (const char*)g.A + (size_t)u.pm * tstep; b = (const char*)g.Bt + (size_t)u.pn * tstep;
    }
};
struct OrderG1 : StaticOrder {
    __device__ __forceinline__ void ptrs(const Gemm& g, const Unit& u, size_t tstep, const char*& a, const char*& b) const {
        const char* pa = (const char*)g.A + (size_t)u.pm * tstep; const char* pb = (const char*)g.Bt + (size_t)u.pn * tstep;
        const bool sw = (u.pn < 4);
        a = sw ? pb : pa; b = sw ? pa : pb;
    }
};

__device__ __forceinline__ unsigned cvt_pk_bf16(float lo, float hi) { unsigned r; asm volatile("v_cvt_pk_bf16_f32 %0, %1, %2" : "=v"(r) : "v"(lo), "v"(hi)); return r; }
__device__ __forceinline__ f32x2 gelu_pk(f32x2 v) {
    const f32x2 av = __builtin_elementwise_abs(v), d = av * 0.2316418882f + 1.0f;
    f32x2 t; t.x = __builtin_amdgcn_rcpf(d.x); t.y = __builtin_amdgcn_rcpf(d.y);
    f32x2 q = t * 0.5307027145f + (-0.7265760135f); q = q * t + 0.7107068705f; q = q * t + (-0.142248368f); q = q * t + 0.127414796f; q = q * t;
    const f32x2 s = (v * v) * (-0.72134752044f);
    f32x2 e; e.x = __builtin_amdgcn_exp2f(s.x); e.y = __builtin_amdgcn_exp2f(s.y);
    const f32x2 m = v * (q * e), r = v - m;
    f32x2 o; o.x = v.x < 0.f ? m.x : r.x; o.y = v.y < 0.f ? m.y : r.y; return o;
}
__device__ __forceinline__ f32x4 gelu4(f32x4 v) { const f32x2 a = gelu_pk((f32x2){v[0], v[1]}), b = gelu_pk((f32x2){v[2], v[3]}); return (f32x4){a.x, a.y, b.x, b.y}; }
__device__ __forceinline__ float silu1(float z) { return z * __builtin_amdgcn_rcpf(1.0f + __builtin_amdgcn_exp2f(z * -1.44269504089f)); }
__device__ __forceinline__ f32x4 silu4(f32x4 v) { return (f32x4){silu1(v[0]), silu1(v[1]), silu1(v[2]), silu1(v[3])}; }

template <class Epi, class Sched, bool ALIGN_EPI = false, bool SP2 = false>
__device__ __forceinline__ void gemm_phase(PG8_LAS unsigned char* lds, const Gemm g, const Sched& S, const Epi& E) {
    const int tid = threadIdx.x, wid = __builtin_amdgcn_readfirstlane(tid >> 6), lane = tid & 63, wr = wid >> 2, wc = wid & 3, fr = lane & 15, fq = lane >> 4;
    const int K = g.K, nt = K / BK;
    unsigned voffA[2], voffB[2];
#pragma unroll
    for (int i = 0; i < 2; ++i) { int R, C; stage_rc(tid * 16 + i * 8192, R, C); const int Rb = Epi::PERM ? ((R & ~31) + perm32(R & 31)) : R;
        voffA[i] = (unsigned)(R * K + C) * 2u; voffB[i] = (unsigned)(Rb * K + C) * 2u; }
    const size_t kstep = (size_t)(BK * 2);
    const size_t hstep = (size_t)HALF * K * 2;
    const size_t tstep = 2 * hstep;
    const unsigned ldsw = (unsigned)wid * 1024u;
    const int aoff = lds_byte(wr * 64 + fr, fq * 8), boff = lds_byte(wc * 32 + fr, fq * 8);
#define PG8_SA(b, h) (((b) * 2 + (h)) * HTB)
#define PG8_SB(b, h) ((4 + (b) * 2 + (h)) * HTB)
#define PG8_STAGE(bufoff, gbase, voff) do { _Pragma("unroll") for (int _i = 0; _i < 2; ++_i) \
        __builtin_amdgcn_global_load_lds((const unsigned*)((const char*)(gbase) + (voff)[_i]), (PG8_LAS unsigned*)(lds + (bufoff) + ldsw + _i * 8192), 16, 0, 0); } while (0)
#define PG8_LDA(dst, b, h) do { _Pragma("unroll") for (int m = 0; m < 4; ++m) _Pragma("unroll") for (int k = 0; k < 2; ++k) dst[m][k] = *(const PG8_LAS bf16x8*)(lds + PG8_SA(b, h) + aoff + m * 2048 + k * 1024); } while (0)
#define PG8_LDB(dst, b, h) do { _Pragma("unroll") for (int n = 0; n < 2; ++n) _Pragma("unroll") for (int k = 0; k < 2; ++k) dst[n][k] = *(const PG8_LAS bf16x8*)(lds + PG8_SB(b, h) + boff + n * 2048 + k * 1024); } while (0)
#define PG8_MMA(ai, bj, At, Bt) do { __builtin_amdgcn_s_setprio(1); _Pragma("unroll") for (int m = 0; m < 4; ++m) _Pragma("unroll") for (int n = 0; n < 2; ++n) _Pragma("unroll") for (int k = 0; k < 2; ++k) \
        acc[ai][bj][m][n] = __builtin_amdgcn_mfma_f32_16x16x32_bf16(Bt[n][k], At[m][k], acc[ai][bj][m][n], 0, 0, 0); __builtin_amdgcn_s_setprio(0); } while (0)
#define PG8_WAIT_V(n) asm volatile("s_waitcnt vmcnt(" #n ")" ::: "memory")
#define PG8_WAIT_L(n) asm volatile("s_waitcnt lgkmcnt(" #n ")" ::: "memory")
#define PG8_BAR __builtin_amdgcn_s_barrier()
#define PG8_SCHED __builtin_amdgcn_sched_barrier(0)
    Unit cur, nxt; int ui = 0;
    if (!S.next(0, cur)) return;
    f32x4 acc[2][2][4][2];
#pragma unroll
    for (int a = 0; a < 2; ++a)
#pragma unroll
        for (int b = 0; b < 2; ++b)
#pragma unroll
            for (int m = 0; m < 4; ++m)
#pragma unroll
                for (int n = 0; n < 2; ++n) acc[a][b][m][n] = (f32x4){0.f, 0.f, 0.f, 0.f};
    bf16x8 At[4][2], B0[2][2], B1[2][2];
    const char* cA; const char* cB; S.ptrs(g, cur, tstep, cA, cB);
    if constexpr (SP2) {
        PG8_STAGE(PG8_SB(0, 0), cB, voffB); PG8_STAGE(PG8_SB(0, 1), cB + hstep, voffB); PG8_STAGE(PG8_SA(0, 0), cA, voffA); PG8_STAGE(PG8_SA(0, 1), cA + hstep, voffA);
        if (wr == 1) PG8_BAR;
        PG8_WAIT_V(2); PG8_BAR;
        PG8_STAGE(PG8_SB(1, 0), cB + kstep, voffB); PG8_STAGE(PG8_SA(1, 0), cA + kstep, voffA); PG8_STAGE(PG8_SB(1, 1), cB + hstep + kstep, voffB);
        PG8_WAIT_V(6); PG8_BAR;
    } else {
        PG8_STAGE(PG8_SB(0, 0), cB, voffB); PG8_STAGE(PG8_SA(0, 0), cA, voffA); PG8_STAGE(PG8_SB(0, 1), cB + hstep, voffB); PG8_STAGE(PG8_SA(0, 1), cA + hstep, voffA);
        if (wr == 1) PG8_BAR;
        PG8_WAIT_V(4); PG8_BAR;
        PG8_STAGE(PG8_SB(1, 0), cB + kstep, voffB); PG8_STAGE(PG8_SA(1, 0), cA + kstep, voffA); PG8_STAGE(PG8_SB(1, 1), cB + hstep + kstep, voffB);
        PG8_WAIT_V(6); PG8_BAR;
    }
    for (;;) {
        const bool has_next = S.next(ui + 1, nxt);
        const char* nA = cA; const char* nB = cB; if (has_next) S.ptrs(g, nxt, tstep, nA, nB);
        for (int t = 0; t < nt; t += 2) {
            const bool last = (t == nt - 2);
            const char* a1 = cA + (size_t)(t + 1) * kstep;
            const char* a2 = last ? nA : cA + (size_t)(t + 2) * kstep; const char* b2 = last ? nB : cB + (size_t)(t + 2) * kstep;
            const char* a3 = a2 + kstep; const char* b3 = b2 + kstep;
            if constexpr (SP2) {
            PG8_LDB(B0, 0, 0); PG8_LDB(B1, 0, 1); PG8_SCHED; PG8_LDA(At, 0, 0); PG8_STAGE(PG8_SA(1, 1), a1 + hstep, voffA);
            PG8_WAIT_V(8); PG8_WAIT_L(0); PG8_BAR; PG8_MMA(0, 0, At, B0); PG8_MMA(0, 1, At, B1); PG8_BAR; PG8_SCHED;
            PG8_LDA(At, 0, 1); PG8_STAGE(PG8_SB(0, 0), b2, voffB); PG8_STAGE(PG8_SB(0, 1), b2 + hstep, voffB); PG8_STAGE(PG8_SA(0, 0), a2, voffA);
            PG8_WAIT_V(8); PG8_WAIT_L(0); PG8_BAR; PG8_MMA(1, 0, At, B0); PG8_MMA(1, 1, At, B1); PG8_BAR; PG8_SCHED;
            PG8_LDB(B0, 1, 0); PG8_LDB(B1, 1, 1); PG8_SCHED; PG8_LDA(At, 1, 0); PG8_STAGE(PG8_SA(0, 1), a2 + hstep, voffA);
            PG8_WAIT_V(8); PG8_WAIT_L(0); PG8_BAR; PG8_MMA(0, 0, At, B0); PG8_MMA(0, 1, At, B1); PG8_BAR; PG8_SCHED;
            PG8_LDA(At, 1, 1); PG8_STAGE(PG8_SB(1, 0), b3, voffB); PG8_STAGE(PG8_SB(1, 1), b3 + hstep, voffB); PG8_STAGE(PG8_SA(1, 0), a3, voffA);
            PG8_WAIT_V(8); PG8_WAIT_L(0); PG8_BAR; PG8_MMA(1, 0, At, B0); PG8_MMA(1, 1, At, B1); PG8_BAR; PG8_SCHED;
            } else {
            PG8_LDB(B0, 0, 0); PG8_SCHED; PG8_LDA(At, 0, 0); PG8_STAGE(PG8_SA(1, 1), a1 + hstep, voffA);
            PG8_WAIT_L(8); PG8_BAR; PG8_WAIT_L(0); PG8_MMA(0, 0, At, B0); PG8_BAR; PG8_SCHED;
            PG8_LDB(B1, 0, 1); PG8_STAGE(PG8_SB(0, 0), b2, voffB);
            PG8_BAR; PG8_WAIT_L(0); PG8_MMA(0, 1, At, B1); PG8_BAR;
            PG8_LDA(At, 0, 1); PG8_STAGE(PG8_SA(0, 0), a2, voffA);
            PG8_BAR; PG8_WAIT_L(0); PG8_MMA(1, 0, At, B0); PG8_BAR; PG8_SCHED;
            PG8_STAGE(PG8_SB(0, 1), b2 + hstep, voffB);
            PG8_WAIT_V(6); PG8_BAR; PG8_MMA(1, 1, At, B1); PG8_BAR;
            PG8_LDB(B0, 1, 0); PG8_SCHED; PG8_LDA(At, 1, 0); PG8_STAGE(PG8_SA(0, 1), a2 + hstep, voffA);
            PG8_WAIT_L(8); PG8_BAR; PG8_WAIT_L(0); PG8_MMA(0, 0, At, B0); PG8_BAR; PG8_SCHED;
            PG8_LDB(B1, 1, 1); PG8_STAGE(PG8_SB(1, 0), b3, voffB);
            PG8_BAR; PG8_WAIT_L(0); PG8_MMA(0, 1, At, B1); PG8_BAR;
            PG8_LDA(At, 1, 1); PG8_STAGE(PG8_SA(1, 0), a3, voffA);
            PG8_BAR; PG8_WAIT_L(0); PG8_MMA(1, 0, At, B0); PG8_BAR; PG8_SCHED;
            PG8_STAGE(PG8_SB(1, 1), b3 + hstep, voffB);
            PG8_WAIT_V(6); PG8_BAR; PG8_MMA(1, 1, At, B1); PG8_BAR;
            }
        }
        if constexpr (ALIGN_EPI) { if (wr == 0) PG8_BAR; }
        if constexpr (!Epi::AFTER_DRAIN) E(acc, cur, wr, wc, fr, fq);
        if (!has_next) break;
#pragma unroll
        for (int a = 0; a < 2; ++a)
#pragma unroll
            for (int b = 0; b < 2; ++b)
#pragma unroll
                for (int m = 0; m < 4; ++m)
#pragma unroll
                    for (int n = 0; n < 2; ++n) acc[a][b][m][n] = (f32x4){0.f, 0.f, 0.f, 0.f};
        cur = nxt; cA = nA; cB = nB; ++ui;
        if constexpr (ALIGN_EPI) { if (wr == 1) PG8_BAR; }
    }
    PG8_WAIT_V(0);
    if constexpr (!ALIGN_EPI) { if (wr == 0) PG8_BAR; }
    PG8_BAR;
    if constexpr (Epi::AFTER_DRAIN) E.fused(acc, cur, wr, wc, fr, fq, lds);
#undef PG8_SA
#undef PG8_SB
#undef PG8_STAGE
#undef PG8_LDA
#undef PG8_LDB
#undef PG8_MMA
#undef PG8_WAIT_V
#undef PG8_WAIT_L
#undef PG8_BAR
#undef PG8_SCHED
}
}

using pg8::bf16_t; using pg8::bf16x8; using pg8::f32x4; using pg8::f32x2; using pg8::u32x4; using pg8::u32x2;
constexpr int DM = 1024, SEQ = 2048, NTOK_P = 16384, NSMP = 128, NTOK = NTOK_P + NSMP, MPAD = 16640, DIN = 7168, DMIX = 2048;
constexpr int N1A = 3072, N1B = 4096;
constexpr float EPS = 1e-5f;
constexpr int NWAVES = 8;
constexpr int XCD_BAR_WORDS_C = 3456;
constexpr size_t MiB = 1u << 20, KiB = 1u << 10;
constexpr size_t WS_VSS = 0, WS_YSS = (size_t)MPAD * 4;
constexpr size_t WS_BAR = 256 * KiB, BAR_BYTES = 65536;
static_assert(WS_YSS + (size_t)MPAD * 4 <= WS_BAR && XCD_BAR_WORDS_C * 4 <= BAR_BYTES, "ctl map");
constexpr size_t WS_BT1 = 1 * MiB, WS_BT2 = 15 * MiB, WS_WSB = 19 * MiB, WS_PAS = 19 * MiB + 512 * KiB, WS_HBS = WS_PAS + 256 * KiB, WS_QBS = WS_HBS + 256 * KiB, WS_GVS = WS_QBS + 256 * KiB;
constexpr size_t WS_XN = 21 * MiB, WS_HB = 54 * MiB, WS_GVTF = 86 * MiB, WS_MIX = 118 * MiB, WS_END = 183 * MiB;
static_assert(WS_BT1 + (size_t)DIN * DM * 2 <= WS_BT2 && WS_BT2 + (size_t)DM * DMIX * 2 <= WS_WSB && WS_WSB + 8 * 128 * 128 * 2 <= WS_PAS && WS_GVS + 256 * KiB <= WS_XN && WS_XN + (size_t)NTOK * DM * 2 <= WS_HB &&
              WS_HB + (size_t)NTOK_P * DM * 2 <= WS_GVTF && WS_GVTF + (size_t)NTOK_P * DM * 2 <= WS_MIX && WS_MIX + (size_t)NTOK * DMIX * 2 <= WS_END, "ws map");
constexpr int LDS_BYTES = 133120 + 20480;
constexpr int WFR_OFF = 133120;


#define LAS __attribute__((address_space(3)))
#define LDS_WAIT() asm volatile("s_waitcnt lgkmcnt(0)" ::: "memory")
__device__ __forceinline__ float bf_lo(unsigned u) { return __uint_as_float(u << 16); }
__device__ __forceinline__ float bf_hi(unsigned u) { return __uint_as_float(u & 0xffff0000u); }
__device__ __forceinline__ float wave_sum(float v) {
#pragma unroll
    for (int o = 1; o < 64; o <<= 1) v += __shfl_xor(v, o);
    return v;
}


#define XB_TMO      128
#define XB_XCNT(j)  (256  + 64 * (j))
#define XB_XSUB(j)  (1280 + 64 * (j))
#define XB_XGEN(j)  (2304 + 64 * (j))
#define XB_TOP      3328
#define XB_TOPGEN   3392
#define XCD_BAR_WORDS 3456
#define XB_SPIN_CAP (1u << 18)
__device__ __forceinline__ unsigned xb_ld(unsigned* p)              { return __hip_atomic_load(p, __ATOMIC_RELAXED, __HIP_MEMORY_SCOPE_AGENT); }
__device__ __forceinline__ unsigned xb_add(unsigned* p, unsigned v) { return __hip_atomic_fetch_add(p, v, __ATOMIC_RELAXED, __HIP_MEMORY_SCOPE_AGENT); }
__device__ __forceinline__ unsigned xb_xcc_id() { return (unsigned)__builtin_amdgcn_s_getreg((3 << 11) | 20) & 0xFu; }
#define XB_SPIN(cond, bar) do { unsigned _sp = 0; while (cond) { __builtin_amdgcn_s_sleep(1); \
    if ((++_sp & 255u) == 0u) { if (xb_ld(&(bar)[XB_TMO])) break; if (_sp > XB_SPIN_CAP) { atomicAdd(&(bar)[XB_TMO], 1u); break; } } } } while (0)
struct XcdBarrier { unsigned* bar; unsigned x; volatile LAS unsigned* st; };
__device__ __forceinline__ XcdBarrier xcd_barrier_post(unsigned* bar, volatile LAS unsigned* st) {
    XcdBarrier b; b.bar = bar; b.x = xb_xcc_id(); b.st = st;
    if (threadIdx.x == 0) (void)xb_add(&bar[XB_XCNT(b.x)], 1u);
    return b;
}
__device__ __forceinline__ void xcd_barrier_complete(unsigned* bar, unsigned x, unsigned& nloc, unsigned& nx) {
    const unsigned G = gridDim.x * gridDim.y * gridDim.z;
    unsigned sum, cnt, mine, sp = 0u;
    for (;;) {
        sum = 0u; cnt = 0u; mine = 0u;
#pragma unroll
        for (unsigned j = 0; j < 16; ++j) { const unsigned c = xb_ld(&bar[XB_XCNT(j)]); sum += c; cnt += (c > 0u) ? 1u : 0u; mine = (j == x) ? c : mine; }
        if (sum == G) break;
        __builtin_amdgcn_s_sleep(1);
        if ((++sp & 255u) == 0u) { if (xb_ld(&bar[XB_TMO])) break; if (sp > XB_SPIN_CAP) { atomicAdd(&bar[XB_TMO], 1u); break; } }
    }
    nloc = mine > 0u ? mine : 1u; nx = cnt > 0u ? cnt : 1u;
}
__device__ __forceinline__ void xcd_barrier(const XcdBarrier& b) {
    asm volatile("s_waitcnt vmcnt(0)" ::: "memory");
    __syncthreads();
    if (threadIdx.x == 0) {
        unsigned* bar = b.bar;
        __builtin_amdgcn_s_waitcnt(0);
        unsigned nloc = b.st[0], nx = b.st[1];
        if (nloc == 0u) { xcd_barrier_complete(bar, b.x, nloc, nx); b.st[0] = nloc; b.st[1] = nx; }
        const unsigned old = xb_add(&bar[XB_XSUB(b.x)], 1u);
        const unsigned gen = old / nloc;
        if (old + 1u == (gen + 1u) * nloc) {
            __builtin_amdgcn_fence(__ATOMIC_RELEASE, "agent");
            asm volatile("s_waitcnt vmcnt(0)" ::: "memory");
            const unsigned og = xb_add(&bar[XB_TOP], 1u);
            const unsigned tg = og / nx;
            if (og + 1u == (tg + 1u) * nx) xb_add(&bar[XB_TOPGEN], 1u);
            else XB_SPIN(xb_ld(&bar[XB_TOPGEN]) == tg, bar);
            __builtin_amdgcn_fence(__ATOMIC_ACQUIRE, "agent");
            xb_add(&bar[XB_XGEN(b.x)], 1u);
            asm volatile("s_waitcnt vmcnt(0)" ::: "memory");
        } else {
            XB_SPIN(xb_ld(&bar[XB_XGEN(b.x)]) == gen, bar);
            __builtin_amdgcn_fence(__ATOMIC_ACQUIRE, "agent");
            asm volatile("s_waitcnt vmcnt(0)" ::: "memory");
        }
    }
    __syncthreads();
}


__device__ __forceinline__ void st16_wt(void* p, pg8::u32x4 v) { asm volatile("global_store_dwordx4 %0, %1, off sc1\n\ts_nop 1" :: "v"(p), "v"(v) : "memory"); }
__device__ __forceinline__ void st8_wt(void* p, unsigned long long v) { asm volatile("global_store_dwordx2 %0, %1, off sc1\n\ts_nop 1" :: "v"(p), "v"(v) : "memory"); }

struct EpiG1a {
    static constexpr bool PERM = true, AFTER_DRAIN = false;
    bf16_t* HB; bf16_t* GVTF; float* vss; PG8_LAS float* xch;
    __device__ __forceinline__ void operator()(const f32x4 (&acc)[2][2][4][2], const pg8::Unit& u, int wr, int wc, int fr, int fq) const {
        const int pn = u.pn;
        if (pn < 4) {
            const int vt = pn;
            float ss[2][2][4];
#pragma unroll
            for (int bj = 0; bj < 2; ++bj)
#pragma unroll
                for (int n = 0; n < 2; ++n)
#pragma unroll
                    for (int j = 0; j < 4; ++j) ss[bj][n][j] = 0.f;
            const int cn = (fr >> 2) & 1;
#pragma unroll
            for (int ai = 0; ai < 2; ++ai)
#pragma unroll
                for (int m = 0; m < 4; ++m) {
                    const int ch = vt * 2 + ai, cwc = wr * 2 + (m >> 1), cfr = 4 * ((m & 1) * 2 + (fr >> 3)) + (fr & 3);
#pragma unroll
                    for (int bj = 0; bj < 2; ++bj) {
                        const f32x4 g0 = pg8::gelu4(acc[ai][bj][m][0]), g1 = pg8::gelu4(acc[ai][bj][m][1]);
#pragma unroll
                        for (int j = 0; j < 4; ++j) { ss[bj][0][j] += g0[j] * g0[j]; ss[bj][1][j] += g1[j] * g1[j]; }
                        u32x4 w; w.x = pg8::cvt_pk_bf16(g0[0], g0[1]); w.y = pg8::cvt_pk_bf16(g0[2], g0[3]); w.z = pg8::cvt_pk_bf16(g1[0], g1[1]); w.w = pg8::cvt_pk_bf16(g1[2], g1[3]);
                        const int c = 2 * u.pm + bj;
                        bf16_t* dst = GVTF + ((((((size_t)c * 8 + ch) * 4 + cwc) * 2 + cn) * 4 + wc) * 512) + (fq * 16 + cfr) * 8;
                        *(u32x4*)dst = w;
                    }
                }
            float mine = 0.f;
#pragma unroll
            for (int bj = 0; bj < 2; ++bj)
#pragma unroll
                for (int n = 0; n < 2; ++n)
#pragma unroll
                    for (int j = 0; j < 4; ++j) {
                        float s = ss[bj][n][j];
                        s += __builtin_bit_cast(float, __builtin_amdgcn_update_dpp(0, __builtin_bit_cast(int, s), 0x128, 0xf, 0xf, false));
                        s += __builtin_bit_cast(float, __builtin_amdgcn_update_dpp(0, __builtin_bit_cast(int, s), 0x124, 0xf, 0xf, false));
                        s += __builtin_bit_cast(float, __builtin_amdgcn_update_dpp(0, __builtin_bit_cast(int, s), 0x122, 0xf, 0xf, false));
                        s += __builtin_bit_cast(float, __builtin_amdgcn_update_dpp(0, __builtin_bit_cast(int, s), 0x121, 0xf, 0xf, false));
                        if (fr == bj * 8 + n * 4 + j) mine = s;
                    }
            const int tokl = (fr >> 3) * 128 + wc * 32 + 8 * fq + (fr & 7);
            if (wr == 1) xch[tokl] = mine;
            asm volatile("s_waitcnt lgkmcnt(0)" ::: "memory"); __builtin_amdgcn_s_barrier(); asm volatile("" ::: "memory");
            if (wr == 0) unsafeAtomicAdd(vss + u.pm * 256 + tokl, mine + xch[tokl]);
        } else {
            const int h = pn - 4;
            const int row0 = u.pm * 256 + wr * 64 + fr, col0 = h * 128 + wc * 32 + 8 * fq;
#pragma unroll
            for (int ai = 0; ai < 2; ++ai)
#pragma unroll
                for (int m = 0; m < 4; ++m) {
                    bf16_t* rowp = HB + (size_t)(row0 + ai * 128 + m * 16) * DM + col0;
                    const f32x4 r0 = acc[ai][0][m][0] * acc[ai][1][m][0], r1 = acc[ai][0][m][1] * acc[ai][1][m][1];
                    u32x4 w; w.x = pg8::cvt_pk_bf16(r0[0], r0[1]); w.y = pg8::cvt_pk_bf16(r0[2], r0[3]); w.z = pg8::cvt_pk_bf16(r1[0], r1[1]); w.w = pg8::cvt_pk_bf16(r1[2], r1[3]);
                    *(u32x4*)rowp = w;
                }
        }
    }
};
struct EpiG1b {
    static constexpr bool PERM = true, AFTER_DRAIN = false;
    const bf16_t* HB; const bf16_t* GVTF; const bf16_t* WSB; const float* vss; const float* g_v; const float* b_s; const float* conv_w; bf16_t* MIX; float* o_scp; PG8_LAS unsigned char* wfr;
    __device__ __forceinline__ void operator()(const f32x4 (&acc)[2][2][4][2], const pg8::Unit& u, int wr, int wc, int fr, int fq) const {
        const int pn = u.pn, lane = fq * 16 + fr;
        if (pn < 8) {
            const int h = pn;
            {
                const int w8 = wr * 4 + wc, st = (w8 * w8 + 2 * w8 + (w8 & 1)) >> 2;
#pragma unroll
                for (int kk = 0; kk < 4; ++kk) if (kk <= (w8 >> 1))
                    *(PG8_LAS u32x4*)(wfr + (st + kk) * 1024 + lane * 16) = *(const u32x4*)(WSB + (size_t)(h * 128 + 16 * w8 + fr) * 128 + 32 * kk + 8 * fq);
                asm volatile("s_waitcnt lgkmcnt(0)" ::: "memory"); __builtin_amdgcn_s_barrier(); asm volatile("" ::: "memory");
            }
            const int nkw = 2 * wr + 2;
            const int d0 = h * 128 + wc * 32 + 8 * fq;
            const f32x4 gva = *(const f32x4*)(g_v + d0), gvb = *(const f32x4*)(g_v + d0 + 4);
#pragma unroll
            for (int ai = 0; ai < 2; ++ai) {
                const int c = 2 * u.pm + ai, tokc = c * 128;
                float iv[4][8]; bf16x8 Bf[2][4]; f32x4 sa[4], sb[4];
#pragma unroll
                for (int kk = 0; kk < 4; ++kk) {
                    if (kk < nkw) {
                        sa[kk] = *(const f32x4*)(vss + tokc + 32 * kk + 8 * fq); sb[kk] = *(const f32x4*)(vss + tokc + 32 * kk + 8 * fq + 4);
#pragma unroll
                        for (int n = 0; n < 2; ++n) Bf[n][kk] = *(const bf16x8*)(GVTF + ((((((size_t)c * 8 + h) * 4 + wc) * 2 + n) * 4 + kk) * 512) + lane * 8);
                    } else {
                        sa[kk] = (f32x4){0.f, 0.f, 0.f, 0.f}; sb[kk] = sa[kk];
#pragma unroll
                        for (int n = 0; n < 2; ++n) Bf[n][kk] = (bf16x8){0, 0, 0, 0, 0, 0, 0, 0};
                    }
                }
                unsigned pk[4][4];
#pragma unroll
                for (int m = 0; m < 4; ++m) {
                    const f32x4 a0 = pg8::gelu4(acc[ai][0][m][0]) * pg8::silu4(acc[ai][1][m][0]), a1 = pg8::gelu4(acc[ai][0][m][1]) * pg8::silu4(acc[ai][1][m][1]);
                    pk[m][0] = pg8::cvt_pk_bf16(a0[0], a0[1]); pk[m][1] = pg8::cvt_pk_bf16(a0[2], a0[3]); pk[m][2] = pg8::cvt_pk_bf16(a1[0], a1[1]); pk[m][3] = pg8::cvt_pk_bf16(a1[2], a1[3]);
                }
#pragma unroll
                for (int kk = 0; kk < 4; ++kk)
#pragma unroll
                    for (int i = 0; i < 4; ++i) { iv[kk][i] = __builtin_amdgcn_rsqf(sa[kk][i] * (1.f / DM) + EPS); iv[kk][4 + i] = __builtin_amdgcn_rsqf(sb[kk][i] * (1.f / DM) + EPS); }
#pragma unroll
                for (int m = 0; m < 4; ++m) {
                    const int t = 64 * wr + 16 * m + fr, nk = 2 * wr + (m >> 1) + 1;
                    f32x4 c0 = (f32x4){0.f, 0.f, 0.f, 0.f}, c1 = c0;
#pragma unroll
                    for (int kk = 0; kk < 4; ++kk) if (kk < nk) {
                        const u32x4 wraw = *(const PG8_LAS u32x4*)(wfr + ((((4 * wr + m) * (4 * wr + m) + 2 * (4 * wr + m) + (m & 1)) >> 2) + kk) * 1024 + lane * 16);
                        u32x4 p;
#pragma unroll
                        for (int q = 0; q < 4; ++q) p[q] = pg8::cvt_pk_bf16(bf_lo(wraw[q]) * iv[kk][2 * q], bf_hi(wraw[q]) * iv[kk][2 * q + 1]);
                        const bf16x8 Af = __builtin_bit_cast(bf16x8, p);
                        c0 = __builtin_amdgcn_mfma_f32_16x16x32_bf16(Bf[0][kk], Af, c0, 0, 0, 0);
                        c1 = __builtin_amdgcn_mfma_f32_16x16x32_bf16(Bf[1][kk], Af, c1, 0, 0, 0);
                    }
                    const int row = u.pm * 256 + ai * 128 + t; const float bias = b_s[h * 128 + t];
                    u32x4 o;
                    o.x = pg8::cvt_pk_bf16(bf_lo(pk[m][0]) * (gva[0] * c0[0] + bias), bf_hi(pk[m][0]) * (gva[1] * c0[1] + bias));
                    o.y = pg8::cvt_pk_bf16(bf_lo(pk[m][1]) * (gva[2] * c0[2] + bias), bf_hi(pk[m][1]) * (gva[3] * c0[3] + bias));
                    o.z = pg8::cvt_pk_bf16(bf_lo(pk[m][2]) * (gvb[0] * c1[0] + bias), bf_hi(pk[m][2]) * (gvb[1] * c1[1] + bias));
                    o.w = pg8::cvt_pk_bf16(bf_lo(pk[m][3]) * (gvb[2] * c1[2] + bias), bf_hi(pk[m][3]) * (gvb[3] * c1[3] + bias));
                    *(u32x4*)(MIX + (size_t)row * DMIX + d0) = o;
                }
            }
        } else {
            const int h = pn - 8, c0 = h * 128 + wc * 32 + 8 * fq;
            float w0[8], w1[8], w2[8];
#pragma unroll
            for (int i = 0; i < 2; ++i) { const f32x4 a = *(const f32x4*)(conv_w + c0 + 4 * i), b = *(const f32x4*)(conv_w + 1024 + c0 + 4 * i), cc = *(const f32x4*)(conv_w + 2048 + c0 + 4 * i);
#pragma unroll
                for (int j = 0; j < 4; ++j) { w0[4 * i + j] = a[j]; w1[4 * i + j] = b[j]; w2[4 * i + j] = cc[j]; } }
#pragma unroll
            for (int ai = 0; ai < 2; ++ai) {
                const int rowb = u.pm * 256 + ai * 128 + wr * 64;
                u32x4 hprev = (u32x4){0u, 0u, 0u, 0u};
                if (fr >= 14 && ((rowb & (SEQ - 1)) != 0)) hprev = *(const u32x4*)(HB + (size_t)(rowb - 16 + fr) * DM + c0);
#pragma unroll
                for (int m = 0; m < 4; ++m) {
                    const f32x4 q0 = acc[ai][0][m][0] * pg8::silu4(acc[ai][1][m][0]), q1 = acc[ai][0][m][1] * pg8::silu4(acc[ai][1][m][1]);
                    const int row = rowb + m * 16 + fr, t = row & (SEQ - 1);
                    const u32x4 h0 = *(const u32x4*)(HB + (size_t)row * DM + c0);
                    u32x4 hm1, hm2;
#pragma unroll
                    for (int p = 0; p < 4; ++p) {
                        const int y1 = (fr == 15) ? (int)hprev[p] : (int)h0[p];
                        const int z2 = (fr >= 14) ? (int)hprev[p] : (int)h0[p];
                        hm1[p] = (unsigned)__builtin_amdgcn_update_dpp(0, y1, 0x121, 0xf, 0xf, false);
                        hm2[p] = (unsigned)__builtin_amdgcn_update_dpp(0, z2, 0x122, 0xf, 0xf, false);
                    }
                    float cv[8];
#pragma unroll
                    for (int p = 0; p < 4; ++p) {
                        cv[2 * p] = w0[2 * p] * bf_lo(hm2[p]) + w1[2 * p] * bf_lo(hm1[p]) + w2[2 * p] * bf_lo(h0[p]);
                        cv[2 * p + 1] = w0[2 * p + 1] * bf_hi(hm2[p]) + w1[2 * p + 1] * bf_hi(hm1[p]) + w2[2 * p + 1] * bf_hi(h0[p]);
                    }
                    u32x4 o; o.x = pg8::cvt_pk_bf16(q0[0] * cv[0], q0[1] * cv[1]); o.y = pg8::cvt_pk_bf16(q0[2] * cv[2], q0[3] * cv[3]); o.z = pg8::cvt_pk_bf16(q1[0] * cv[4], q1[1] * cv[5]); o.w = pg8::cvt_pk_bf16(q1[2] * cv[6], q1[3] * cv[7]);
                    *(u32x4*)(MIX + (size_t)row * DMIX + DM + c0) = o;
                    if (t >= SEQ - 2) {
                        float* dst = o_scp + ((size_t)(row / SEQ) * 2 + (t - (SEQ - 2))) * DM + c0;
                        *(f32x4*)dst = (f32x4){bf_lo(h0[0]), bf_hi(h0[0]), bf_lo(h0[1]), bf_hi(h0[1])}; *(f32x4*)(dst + 4) = (f32x4){bf_lo(h0[2]), bf_hi(h0[2]), bf_lo(h0[3]), bf_hi(h0[3])};
                    }
                    hprev = h0;
                }
            }
        }
    }
};
struct EpiG2 {
    static constexpr bool PERM = false, AFTER_DRAIN = false;
    const float* x; float* out; float* yss;
    __device__ __forceinline__ void operator()(const f32x4 (&acc)[2][2][4][2], const pg8::Unit& u, int wr, int wc, int fr, int fq) const {
        const int row0 = u.pm * 256 + wr * 64 + fr, col0 = u.pn * 256 + wc * 32 + 4 * fq;
#pragma unroll
        for (int ai = 0; ai < 2; ++ai)
#pragma unroll
            for (int m = 0; m < 4; ++m) {
                const int row = row0 + ai * 128 + m * 16; const size_t off = (size_t)row * DM + col0; float s = 0.f;
#pragma unroll
                for (int bj = 0; bj < 2; ++bj)
#pragma unroll
                    for (int n = 0; n < 2; ++n) { const f32x4 xv = *(const f32x4*)(x + off + bj * 128 + n * 16); const f32x4 y = xv + acc[ai][bj][m][n];
                        *(f32x4*)(out + off + bj * 128 + n * 16) = y; s += (y[0] * y[0] + y[1] * y[1]) + (y[2] * y[2] + y[3] * y[3]); }
                s += __shfl_xor(s, 16); s += __shfl_xor(s, 32);
                if (fq == 0) unsafeAtomicAdd(yss + row, s);
            }
    }
};

__device__ __forceinline__ void spin_until(unsigned* p, unsigned want) {
    unsigned sp = 0u;
    while (__hip_atomic_load(p, __ATOMIC_RELAXED, __HIP_MEMORY_SCOPE_AGENT) < want) { __builtin_amdgcn_s_sleep(1); if (++sp > (1u << 22)) break; }
}
struct EpiG2f {
    static constexpr bool PERM = false, AFTER_DRAIN = true;
    const float* x; float* out; float* yss; unsigned* cnt; const float* gfin;
    __device__ __forceinline__ void operator()(const f32x4 (&acc)[2][2][4][2], const pg8::Unit& u, int wr, int wc, int fr, int fq) const {}
    __device__ __forceinline__ void fused(f32x4 (&acc)[2][2][4][2], const pg8::Unit& u, int wr, int wc, int fr, int fq, PG8_LAS unsigned char* lds) const {
        const int row0 = u.pm * 256 + wr * 64 + fr, col0 = u.pn * 256 + wc * 32 + 4 * fq;
        PG8_LAS float* part = (PG8_LAS float*)lds;
#pragma unroll
        for (int ai = 0; ai < 2; ++ai)
#pragma unroll
            for (int m = 0; m < 4; ++m) {
                const int row = row0 + ai * 128 + m * 16; const size_t off = (size_t)row * DM + col0; float s = 0.f;
#pragma unroll
                for (int bj = 0; bj < 2; ++bj)
#pragma unroll
                    for (int n = 0; n < 2; ++n) { const f32x4 xv = __builtin_nontemporal_load((const f32x4*)(x + off + bj * 128 + n * 16)); const f32x4 y = xv + acc[ai][bj][m][n];
                        acc[ai][bj][m][n] = y; s += (y[0] * y[0] + y[1] * y[1]) + (y[2] * y[2] + y[3] * y[3]); }
                s += __shfl_xor(s, 16); s += __shfl_xor(s, 32);
                if (fq == 0) part[wc * 256 + ai * 128 + wr * 64 + m * 16 + fr] = s;
                if (m == 3) asm volatile("" ::: "memory");
            }
        asm volatile("s_waitcnt lgkmcnt(0)" ::: "memory"); __builtin_amdgcn_s_barrier(); asm volatile("" ::: "memory");
        const int tid_ = threadIdx.x;
        if (tid_ < 256) {
            unsafeAtomicAdd(yss + u.pm * 256 + tid_, (part[tid_] + part[256 + tid_]) + (part[512 + tid_] + part[768 + tid_]));
            asm volatile("s_waitcnt vmcnt(0)" ::: "memory");
            if ((tid_ & 63) == 0) __hip_atomic_fetch_add(cnt + 64 * u.pm, 1u, __ATOMIC_RELAXED, __HIP_MEMORY_SCOPE_AGENT);
        }
        f32x4 gf[2][2];
#pragma unroll
        for (int bj = 0; bj < 2; ++bj)
#pragma unroll
            for (int n = 0; n < 2; ++n) gf[bj][n] = *(const f32x4*)(gfin + col0 + bj * 128 + n * 16);
        spin_until(cnt + 64 * u.pm, 16u);
#pragma unroll
        for (int ai = 0; ai < 2; ++ai)
#pragma unroll
            for (int m = 0; m < 4; ++m) {
                const int row = row0 + ai * 128 + m * 16; const size_t off = (size_t)row * DM + col0;
                const float ss = __hip_atomic_load(yss + row, __ATOMIC_RELAXED, __HIP_MEMORY_SCOPE_AGENT);
                const float inv = __builtin_amdgcn_rsqf(ss * (1.f / DM) + EPS);
#pragma unroll
                for (int bj = 0; bj < 2; ++bj)
#pragma unroll
                    for (int n = 0; n < 2; ++n) __builtin_nontemporal_store(acc[ai][bj][m][n] * inv * gf[bj][n], (f32x4*)(out + off + bj * 128 + n * 16));
            }
    }
};

struct Args { const float* in[11]; float* out; unsigned char* ws; int ph_lo, ph_hi; };

__device__ __forceinline__ int perm_row(int n) {
    const int sec = n >> 10, r = n & 1023, h = r >> 7, j = r & 127;
    switch (sec) {
        case 1: return r;
        case 3: return (4 + h) * 256 + j;
        case 5: return (4 + h) * 256 + 128 + j;
        case 0: return (12 + h) * 256 + j;
        case 2: return (12 + h) * 256 + 128 + j;
        case 4: return (20 + h) * 256 + j;
        default: return (20 + h) * 256 + 128 + j;
    }
}
__device__ __forceinline__ void p0_load_item(const float* __restrict__ W, int N, int item, int lane, f32x4 (&v)[8]) {
    const int nblk = N / 32, kb = item / nblk, nb = item % nblk;
    const float* p = W + (size_t)(64 * kb + 8 * (lane >> 3)) * N + 32 * nb + 4 * (lane & 7);
#pragma unroll
    for (int i = 0; i < 8; ++i) v[i] = __builtin_nontemporal_load((const f32x4*)(p + (size_t)i * N));
}
__device__ __forceinline__ void p0_store_item(bf16_t* __restrict__ WT, int K, int N, bool perm, int item, int lane, const f32x4 (&v)[8]) {
    const int nblk = N / 32, kb = item / nblk, nb = item % nblk, n0 = 32 * nb;
    const int r0 = perm ? perm_row(n0) : n0;
    bf16_t* q = WT + (size_t)(r0 + 4 * (lane & 7)) * K + 64 * kb + 8 * (lane >> 3);
#pragma unroll
    for (int j = 0; j < 4; ++j) {
        u32x4 o; o.x = pg8::cvt_pk_bf16(v[0][j], v[1][j]); o.y = pg8::cvt_pk_bf16(v[2][j], v[3][j]); o.z = pg8::cvt_pk_bf16(v[4][j], v[5][j]); o.w = pg8::cvt_pk_bf16(v[6][j], v[7][j]);
        st16_wt(q + (size_t)j * K, o);
    }
}

__global__ void __launch_bounds__(NWAVES * 64, 2) fwd_kernel(Args args) {
    extern __shared__ __attribute__((aligned(16))) unsigned char lds_raw[];
    LAS unsigned char* lds = (LAS unsigned char*)lds_raw;
    cg::grid_group grid = cg::this_grid();
    const int tid = threadIdx.x, lane = tid & 63, wave = __builtin_amdgcn_readfirstlane(tid >> 6);
    const int G = gridDim.x, bx = blockIdx.x;
    const int gw = bx * NWAVES + wave, NGW = G * NWAVES;
    const int fr = lane & 15, fq = lane >> 4;
    unsigned char* ws = args.ws;
    const float* x_prompt = args.in[0]; const float* x_sample = args.in[1]; const float* state_conv = args.in[2]; const float* g_norm = args.in[3];
    const float* w_in = args.in[4]; const float* w_s = args.in[5]; const float* b_s = args.in[6]; const float* g_v = args.in[7];
    const float* conv_w = args.in[8]; const float* w_out = args.in[9]; const float* g_final = args.in[10];
    float* out = args.out;
    float* vss = (float*)(ws + WS_VSS); float* yss = (float*)(ws + WS_YSS);
    bf16_t* BT1 = (bf16_t*)(ws + WS_BT1); bf16_t* BT2 = (bf16_t*)(ws + WS_BT2); bf16_t* WSB = (bf16_t*)(ws + WS_WSB); bf16_t* XN = (bf16_t*)(ws + WS_XN);
    bf16_t* PAS = (bf16_t*)(ws + WS_PAS); bf16_t* HBS = (bf16_t*)(ws + WS_HBS); bf16_t* QBS = (bf16_t*)(ws + WS_QBS); bf16_t* GVS = (bf16_t*)(ws + WS_GVS);
    bf16_t* HB = (bf16_t*)(ws + WS_HB); bf16_t* GVTF = (bf16_t*)(ws + WS_GVTF); bf16_t* MIX = (bf16_t*)(ws + WS_MIX);
    float* y_all = out;
    float* o_scp = out + (size_t)NTOK * DM;
    float* o_scs = o_scp + 8 * 2 * 1024;
    float* o_svs = o_scs + 128 * 2 * 1024;
    const int lo = args.ph_lo, hi = args.ph_hi;
    volatile LAS unsigned* MISC = (volatile LAS unsigned*)(lds + 131072);
    if (tid < 16) MISC[tid] = 0u;
    __syncthreads();
    XcdBarrier xbar = xcd_barrier_post((unsigned*)(ws + WS_BAR), MISC + 8);
    if (lo > 1000) grid.sync();
#define IN(k) (lo <= (k) && (k) < hi)
#define BOTH(k) (IN(k) && IN((k) + 1))
#define GSYNC() do { xcd_barrier(xbar); } while (0)

    if (IN(0)) {
        constexpr int I_1 = (DM / 64) * (DIN / 32), I_2 = (DMIX / 64) * (DM / 32);
        for (int it = gw; it < I_1 + I_2; it += 2 * NGW) {
            const int it2 = it + NGW; const bool has2 = it2 < I_1 + I_2;
            f32x4 va[8], vb[8];
            if (it < I_1) p0_load_item(w_in, DIN, it, lane, va); else p0_load_item(w_out, DM, it - I_1, lane, va);
            if (has2) { if (it2 < I_1) p0_load_item(w_in, DIN, it2, lane, vb); else p0_load_item(w_out, DM, it2 - I_1, lane, vb); }
            if (it < I_1) p0_store_item(BT1, DM, DIN, true, it, lane, va); else p0_store_item(BT2, DMIX, DM, false, it - I_1, lane, va);
            if (has2) { if (it2 < I_1) p0_store_item(BT1, DM, DIN, true, it2, lane, vb); else p0_store_item(BT2, DMIX, DM, false, it2 - I_1, lane, vb); }
        }
        f32x4 gn[4];
#pragma unroll
        for (int j = 0; j < 4; ++j) gn[j] = *((const f32x4*)g_norm + lane + 64 * j);
        for (int m0 = gw; m0 < NTOK; m0 += 4 * NGW) {
            f32x4 v[4][4]; float s[4];
#pragma unroll
            for (int r = 0; r < 4; ++r) {
                const int m = m0 + r * NGW; s[r] = 0.f;
                if (m < NTOK) {
                    const float* xrow = m < NTOK_P ? x_prompt + (size_t)m * DM : x_sample + (size_t)(m - NTOK_P) * DM;
                    const f32x4* xr = (const f32x4*)xrow + lane;
#pragma unroll
                    for (int j = 0; j < 4; ++j) v[r][j] = __builtin_nontemporal_load(xr + 64 * j);
                } else {
#pragma unroll
                    for (int j = 0; j < 4; ++j) v[r][j] = (f32x4){0.f, 0.f, 0.f, 0.f};
                }
            }
#pragma unroll
            for (int r = 0; r < 4; ++r) {
#pragma unroll
                for (int j = 0; j < 4; ++j) s[r] += (v[r][j][0] * v[r][j][0] + v[r][j][1] * v[r][j][1]) + (v[r][j][2] * v[r][j][2] + v[r][j][3] * v[r][j][3]);
                s[r] = wave_sum(s[r]);
            }
#pragma unroll
            for (int r = 0; r < 4; ++r) {
                const int m = m0 + r * NGW;
                if (m < NTOK) {
                    unsigned long long* o8 = (unsigned long long*)(XN + (size_t)m * DM) + lane;
                    const float inv = __builtin_amdgcn_rsqf(s[r] * (1.f / DM) + EPS);
#pragma unroll
                    for (int j = 0; j < 4; ++j) { const f32x4 t = v[r][j] * inv * gn[j];
                        st8_wt(o8 + 64 * j, (unsigned long long)pg8::cvt_pk_bf16(t[0], t[1]) | ((unsigned long long)pg8::cvt_pk_bf16(t[2], t[3]) << 32)); }
                }
            }
        }
        for (int i = bx * (NWAVES * 64) + tid; i < 2 * MPAD; i += G * NWAVES * 64) vss[i] = 0.f;
        for (int i = bx * (NWAVES * 64) + tid; i < 8 * 128 * 128 / 8; i += G * NWAVES * 64) {
            const int e0 = i * 8, t = (e0 >> 7) & 127, s0 = e0 & 127;
            const f32x4 a = __builtin_nontemporal_load((const f32x4*)(w_s + e0)), b = __builtin_nontemporal_load((const f32x4*)(w_s + e0 + 4));
            u32x4 p; p.x = pg8::cvt_pk_bf16(s0 <= t ? a[0] : 0.f, s0 + 1 <= t ? a[1] : 0.f); p.y = pg8::cvt_pk_bf16(s0 + 2 <= t ? a[2] : 0.f, s0 + 3 <= t ? a[3] : 0.f);
            p.z = pg8::cvt_pk_bf16(s0 + 4 <= t ? b[0] : 0.f, s0 + 5 <= t ? b[1] : 0.f); p.w = pg8::cvt_pk_bf16(s0 + 6 <= t ? b[2] : 0.f, s0 + 7 <= t ? b[3] : 0.f);
            *(u32x4*)(WSB + e0) = p;
        }
        if (BOTH(0)) GSYNC();
    }

    if (IN(1)) {
        {
            pg8::Gemm g{XN, BT1, NTOK_P, N1A, DM}; pg8::OrderG1 S; S.init(NTOK_P, N1A, G, bx);
            EpiG1a E{HB, GVTF, vss, (LAS float*)(lds + 131072 + 256)};
            pg8::gemm_phase<EpiG1a, pg8::OrderG1, true, true>(lds, g, S, E);
        }
        const bool shared_tail = (G >= 224);
        if (shared_tail && bx < 224) {
            const int T = bx >> 3, ct = bx & 7;
#pragma unroll
            for (int i = 0; i < 8; ++i) { const int p = tid + 512 * i, row = p >> 7, c16 = p & 127;
                const u32x4 v = *(const u32x4*)(BT1 + (size_t)(T * 256 + (row >> 4) * 128 + 16 * ct + (row & 15)) * DM + c16 * 8);
                *(LAS u32x4*)(lds + row * 2064 + c16 * 16) = v; }
            __syncthreads();
        }
        for (int t = shared_tail ? (bx < 224 ? bx * 8 + wave : 8 * 28 * 8) : wave * G + bx; t < 8 * 28 * 8; t += shared_tail ? 8 * 28 * 8 : NGW) {
            const int tb = t & 7, ct = (t >> 3) & 7, T = t >> 6;
            const bf16_t* ap = XN + (size_t)(NTOK_P + 16 * tb + fr) * DM + 8 * fq;
            f32x4 a0 = (f32x4){0.f, 0.f, 0.f, 0.f}, a1 = a0;
            if (shared_tail) {
                const LAS unsigned char* lb0 = lds + fr * 2064 + fq * 16; const LAS unsigned char* lb1 = lb0 + 16 * 2064;
#pragma unroll 16
                for (int kk = 0; kk < DM / 32; ++kk) {
                    const bf16x8 af = *(const bf16x8*)(ap + 32 * kk);
                    a0 = __builtin_amdgcn_mfma_f32_16x16x32_bf16(*(const LAS bf16x8*)(lb0 + 64 * kk), af, a0, 0, 0, 0);
                    a1 = __builtin_amdgcn_mfma_f32_16x16x32_bf16(*(const LAS bf16x8*)(lb1 + 64 * kk), af, a1, 0, 0, 0);
                }
            } else {
                const bf16_t* bp0 = BT1 + (size_t)(T * 256 + 16 * ct + fr) * DM + 8 * fq; const bf16_t* bp1 = bp0 + (size_t)128 * DM;
#pragma unroll 16
                for (int kk = 0; kk < DM / 32; ++kk) {
                    const bf16x8 af = *(const bf16x8*)(ap + 32 * kk);
                    a0 = __builtin_amdgcn_mfma_f32_16x16x32_bf16(*(const bf16x8*)(bp0 + 32 * kk), af, a0, 0, 0, 0);
                    a1 = __builtin_amdgcn_mfma_f32_16x16x32_bf16(*(const bf16x8*)(bp1 + 32 * kk), af, a1, 0, 0, 0);
                }
            }
            const int srow = 16 * tb + fr, cl = 16 * ct + 4 * fq;
            if (T < 4) {
                const f32x4 g0 = pg8::gelu4(a0), g1 = pg8::gelu4(a1);
                u32x2 w0; w0.x = pg8::cvt_pk_bf16(g0[0], g0[1]); w0.y = pg8::cvt_pk_bf16(g0[2], g0[3]);
                u32x2 w1; w1.x = pg8::cvt_pk_bf16(g1[0], g1[1]); w1.y = pg8::cvt_pk_bf16(g1[2], g1[3]);
                *(u32x2*)(GVS + (size_t)srow * DM + T * 256 + cl) = w0; *(u32x2*)(GVS + (size_t)srow * DM + T * 256 + 128 + cl) = w1;
                float s = (g0[0] * g0[0] + g0[1] * g0[1]) + (g0[2] * g0[2] + g0[3] * g0[3]) + (g1[0] * g1[0] + g1[1] * g1[1]) + (g1[2] * g1[2] + g1[3] * g1[3]);
                s += __shfl_xor(s, 16); s += __shfl_xor(s, 32);
                if (fq == 0) unsafeAtomicAdd(vss + NTOK_P + srow, s);
            } else {
                const int mode = T < 12 ? 1 : (T < 20 ? 0 : 2), h = T < 12 ? T - 4 : (T < 20 ? T - 12 : T - 20);
                f32x4 r;
                if (mode == 1) r = a0 * a1; else if (mode == 0) r = pg8::gelu4(a0) * pg8::silu4(a1); else r = a0 * pg8::silu4(a1);
                bf16_t* O = (bf16_t*)(ws + (mode == 1 ? WS_HBS : (mode == 0 ? WS_PAS : WS_QBS)));
                u32x2 w; w.x = pg8::cvt_pk_bf16(r[0], r[1]); w.y = pg8::cvt_pk_bf16(r[2], r[3]);
                *(u32x2*)(O + (size_t)srow * DM + h * 128 + cl) = w;
            }
        }
        if (BOTH(1)) GSYNC();
    }

    if (IN(2)) {
        for (int item = bx * (NWAVES * 64) + tid; item < NSMP * 256; item += G * NWAVES * 64) {
            const int b = item >> 8, cg8 = item & 255, row = NTOK_P + b;
            if (cg8 < 128) {
                const int c0 = cg8 * 8, h = c0 >> 7;
                const float inv = __builtin_amdgcn_rsqf(vss[row] * (1.f / DM) + EPS), w00 = w_s[(size_t)h * 128 * 128], b0 = b_s[h * 128];
                const u32x4 pa = *(const u32x4*)(PAS + (size_t)b * DM + c0), gv = *(const u32x4*)(GVS + (size_t)b * DM + c0);
                const f32x4 ga = *(const f32x4*)(g_v + c0), gb = *(const f32x4*)(g_v + c0 + 4);
                float vn[8], o[8];
#pragma unroll
                for (int p = 0; p < 4; ++p) { vn[2 * p] = bf_lo(gv[p]) * inv; vn[2 * p + 1] = bf_hi(gv[p]) * inv; }
#pragma unroll
                for (int i = 0; i < 4; ++i) { vn[i] *= ga[i]; vn[4 + i] *= gb[i]; }
#pragma unroll
                for (int p = 0; p < 4; ++p) { o[2 * p] = bf_lo(pa[p]) * (w00 * vn[2 * p] + b0); o[2 * p + 1] = bf_hi(pa[p]) * (w00 * vn[2 * p + 1] + b0); }
                u32x4 ov; ov.x = pg8::cvt_pk_bf16(o[0], o[1]); ov.y = pg8::cvt_pk_bf16(o[2], o[3]); ov.z = pg8::cvt_pk_bf16(o[4], o[5]); ov.w = pg8::cvt_pk_bf16(o[6], o[7]);
                *(u32x4*)(MIX + (size_t)row * DMIX + c0) = ov;
                float* dv = o_svs + (size_t)b * DM + c0;
                *(f32x4*)dv = (f32x4){vn[0], vn[1], vn[2], vn[3]}; *(f32x4*)(dv + 4) = (f32x4){vn[4], vn[5], vn[6], vn[7]};
            } else {
                const int c0 = (cg8 - 128) * 8;
                const u32x4 h0 = *(const u32x4*)(HBS + (size_t)b * DM + c0), q = *(const u32x4*)(QBS + (size_t)b * DM + c0);
                const float* st0 = state_conv + ((size_t)b * 2 + 0) * DM + c0; const float* st1 = state_conv + ((size_t)b * 2 + 1) * DM + c0;
                float s0[8], s1[8], hv[8], qv[8], o[8];
#pragma unroll
                for (int i = 0; i < 2; ++i) { const f32x4 a = __builtin_nontemporal_load((const f32x4*)(st0 + 4 * i)), bb = __builtin_nontemporal_load((const f32x4*)(st1 + 4 * i));
#pragma unroll
                    for (int j = 0; j < 4; ++j) { s0[4 * i + j] = a[j]; s1[4 * i + j] = bb[j]; } }
#pragma unroll
                for (int p = 0; p < 4; ++p) { hv[2 * p] = bf_lo(h0[p]); hv[2 * p + 1] = bf_hi(h0[p]); qv[2 * p] = bf_lo(q[p]); qv[2 * p + 1] = bf_hi(q[p]); }
#pragma unroll
                for (int i = 0; i < 8; ++i) o[i] = qv[i] * (conv_w[c0 + i] * s0[i] + conv_w[1024 + c0 + i] * s1[i] + conv_w[2048 + c0 + i] * hv[i]);
                u32x4 ov; ov.x = pg8::cvt_pk_bf16(o[0], o[1]); ov.y = pg8::cvt_pk_bf16(o[2], o[3]); ov.z = pg8::cvt_pk_bf16(o[4], o[5]); ov.w = pg8::cvt_pk_bf16(o[6], o[7]);
                *(u32x4*)(MIX + (size_t)row * DMIX + DM + c0) = ov;
                float* d0 = o_scs + ((size_t)b * 2 + 0) * DM + c0; float* d1 = d0 + DM;
                *(f32x4*)d0 = (f32x4){s1[0], s1[1], s1[2], s1[3]}; *(f32x4*)(d0 + 4) = (f32x4){s1[4], s1[5], s1[6], s1[7]};
                *(f32x4*)d1 = (f32x4){hv[0], hv[1], hv[2], hv[3]}; *(f32x4*)(d1 + 4) = (f32x4){hv[4], hv[5], hv[6], hv[7]};
            }
        }
        {
            pg8::Gemm g{XN, BT1 + (size_t)N1A * DM, NTOK_P, N1B, DM}; pg8::StaticOrder S; S.init(NTOK_P, N1B, G, bx);
            EpiG1b E{HB, GVTF, WSB, vss, g_v, b_s, conv_w, MIX, o_scp, lds + WFR_OFF};
            pg8::gemm_phase<EpiG1b, pg8::StaticOrder, true, true>(lds, g, S, E);
        }
        if (BOTH(2)) GSYNC();
    }

    const bool fusedn = (G == 256);
    if (IN(3)) {
        unsigned* cw = (unsigned*)(ws + WS_BAR);
        if (fusedn) {
            pg8::Gemm g{MIX, BT2, NTOK_P, DM, DMIX}; pg8::StaticOrder S; S.init(NTOK_P, DM, G, bx);
            EpiG2f E{x_prompt, y_all, yss, cw + 4096, g_final};
            pg8::gemm_phase<EpiG2f, pg8::StaticOrder, false, true>(lds, g, S, E);
        } else {
            pg8::Gemm g{MIX, BT2, NTOK_P, DM, DMIX}; pg8::StaticOrder S; S.init(NTOK_P, DM, G, bx);
            EpiG2 E{x_prompt, y_all, yss};
            pg8::gemm_phase<EpiG2, pg8::StaticOrder, true, true>(lds, g, S, E);
        }
        if (fusedn) {
            const int t = bx * 2 + (wave >> 2), q = wave & 3, tb = t & 7, nb = t >> 3;
            const bf16_t* ap = MIX + (size_t)(NTOK_P + 16 * tb + fr) * DMIX + q * 512 + 8 * fq; const bf16_t* bp = BT2 + (size_t)(16 * nb + fr) * DMIX + q * 512 + 8 * fq;
            bf16x8 af[16], bf[16];
#pragma unroll
            for (int kk = 0; kk < 16; ++kk) { af[kk] = *(const bf16x8*)(ap + 32 * kk); bf[kk] = *(const bf16x8*)(bp + 32 * kk); }
            const int srow = 16 * tb + fr, col = 16 * nb + 4 * fq;
            const f32x4 xs = __builtin_nontemporal_load((const f32x4*)(x_sample + (size_t)srow * DM + col)), gf = *(const f32x4*)(g_final + col);
            f32x4 a0 = (f32x4){0.f, 0.f, 0.f, 0.f}, a1 = a0;
#pragma unroll
            for (int kk = 0; kk < 16; kk += 2) { a0 = __builtin_amdgcn_mfma_f32_16x16x32_bf16(bf[kk], af[kk], a0, 0, 0, 0); a1 = __builtin_amdgcn_mfma_f32_16x16x32_bf16(bf[kk + 1], af[kk + 1], a1, 0, 0, 0); }
            LAS f32x4* part = (LAS f32x4*)lds;
            part[wave * 64 + lane] = a0 + a1;
            __syncthreads();
            if (q == 0) {
                f32x4 y = xs + part[wave * 64 + lane] + part[(wave + 1) * 64 + lane] + part[(wave + 2) * 64 + lane] + part[(wave + 3) * 64 + lane];
                float s = (y[0] * y[0] + y[1] * y[1]) + (y[2] * y[2] + y[3] * y[3]);
                s += __shfl_xor(s, 16); s += __shfl_xor(s, 32);
                if (fq == 0) unsafeAtomicAdd(yss + NTOK_P + srow, s);
                asm volatile("s_waitcnt vmcnt(0)" ::: "memory");
                if (lane == 0) __hip_atomic_fetch_add(cw + 8192 + 64 * tb, 1u, __ATOMIC_RELAXED, __HIP_MEMORY_SCOPE_AGENT);
                spin_until(cw + 8192 + 64 * tb, 64u);
                const float ss = __hip_atomic_load(yss + NTOK_P + srow, __ATOMIC_RELAXED, __HIP_MEMORY_SCOPE_AGENT);
                y = y * __builtin_amdgcn_rsqf(ss * (1.f / DM) + EPS) * gf;
                *(f32x4*)(y_all + (size_t)(NTOK_P + srow) * DM + col) = y;
            }
        } else
        for (int t = wave * G + bx; t < (NSMP / 16) * (DM / 16); t += NGW) {
            const int tb = t & 7, nb = t >> 3;
            const bf16_t* ap = MIX + (size_t)(NTOK_P + 16 * tb + fr) * DMIX + 8 * fq; const bf16_t* bp = BT2 + (size_t)(16 * nb + fr) * DMIX + 8 * fq;
            f32x4 a0 = (f32x4){0.f, 0.f, 0.f, 0.f}, a1 = a0;
#pragma unroll 8
            for (int kk = 0; kk < DMIX / 32; kk += 2) {
                a0 = __builtin_amdgcn_mfma_f32_16x16x32_bf16(*(const bf16x8*)(bp + 32 * kk), *(const bf16x8*)(ap + 32 * kk), a0, 0, 0, 0);
                a1 = __builtin_amdgcn_mfma_f32_16x16x32_bf16(*(const bf16x8*)(bp + 32 * kk + 32), *(const bf16x8*)(ap + 32 * kk + 32), a1, 0, 0, 0);
            }
            const int srow = 16 * tb + fr, col = 16 * nb + 4 * fq;
            f32x4 y = *(const f32x4*)(x_sample + (size_t)srow * DM + col) + a0 + a1;
            float s = (y[0] * y[0] + y[1] * y[1]) + (y[2] * y[2] + y[3] * y[3]);
            s += __shfl_xor(s, 16); s += __shfl_xor(s, 32);
            if (fq == 0) unsafeAtomicAdd(yss + NTOK_P + srow, s);
            if (fusedn) {
                asm volatile("s_waitcnt vmcnt(0)" ::: "memory");
                if (lane == 0) __hip_atomic_fetch_add(cw + 8192 + 64 * tb, 1u, __ATOMIC_RELAXED, __HIP_MEMORY_SCOPE_AGENT);
                const f32x4 gf = *(const f32x4*)(g_final + col);
                spin_until(cw + 8192 + 64 * tb, 64u);
                const float ss = __hip_atomic_load(yss + NTOK_P + srow, __ATOMIC_RELAXED, __HIP_MEMORY_SCOPE_AGENT);
                y = y * __builtin_amdgcn_rsqf(ss * (1.f / DM) + EPS) * gf;
            }
            *(f32x4*)(y_all + (size_t)(NTOK_P + srow) * DM + col) = y;
        }
        if (BOTH(3) && !fusedn) GSYNC();
    }

    if (IN(4) && !fusedn) {
        f32x4 gf[4];
#pragma unroll
        for (int j = 0; j < 4; ++j) gf[j] = *((const f32x4*)g_final + lane + 64 * j);
        for (int m = gw; m < NTOK; m += NGW) {
            const float inv = 1.0f / sqrtf(yss[m] * (1.f / DM) + EPS);
            f32x4* yr = (f32x4*)(y_all + (size_t)m * DM) + lane;
#pragma unroll
            for (int j = 0; j < 4; ++j) yr[64 * j] = yr[64 * j] * inv * gf[j];
        }
    }
#undef IN
#undef BOTH
#undef GSYNC
}

extern "C" void kernel_launch(void* const* d_in, const int* in_sizes, int n_in, void* d_out, int out_size, void* d_ws, size_t ws_size, hipStream_t stream) {
    static int grid = 0;
    if (grid == 0) {
        int dev = 0, cus = 0, per_cu = 0;
        if (hipGetDevice(&dev) != hipSuccess || hipDeviceGetAttribute(&cus, hipDeviceAttributeMultiprocessorCount, dev) != hipSuccess) { fprintf(stderr, "kernel_launch: device query failed\n"); grid = -1; return; }
        if (hipFuncSetAttribute((const void*)fwd_kernel, hipFuncAttributeMaxDynamicSharedMemorySize, LDS_BYTES) != hipSuccess) { fprintf(stderr, "kernel_launch: hipFuncSetAttribute failed\n"); grid = -1; return; }
        if (hipOccupancyMaxActiveBlocksPerMultiprocessor(&per_cu, (const void*)fwd_kernel, NWAVES * 64, LDS_BYTES) != hipSuccess || per_cu < 1) { fprintf(stderr, "kernel_launch: occupancy query says %d blocks per CU\n", per_cu); (void)hipGetLastError(); grid = -1; return; }
        grid = cus;
        if (n_in != 11 || ws_size < WS_END) { fprintf(stderr, "kernel_launch: unexpected inputs (n_in %d, ws %zu)\n", n_in, ws_size); grid = -1; return; }
    }
    if (grid < 0) return;
    if (hipMemsetAsync((char*)d_ws + WS_BAR, 0, BAR_BYTES, stream) != hipSuccess) { fprintf(stderr, "kernel_launch: memset failed\n"); return; }
    Args a{};
    for (int i = 0; i < 11; ++i) a.in[i] = (const float*)d_in[i];
    a.out = (float*)d_out; a.ws = (unsigned char*)d_ws;
#if MK_N_LAUNCHES == 1
    a.ph_lo = 0; a.ph_hi = 5;
    void* kargs[] = {&a};
    hipError_t e = hipLaunchCooperativeKernel((const void*)fwd_kernel, dim3(grid), dim3(NWAVES * 64), kargs, LDS_BYTES, stream);
    if (e != hipSuccess) fprintf(stderr, "kernel_launch: cooperative launch failed: %s (grid %d)\n", hipGetErrorString(e), grid);
#else
    for (int p = 0; p < 5; ++p) { a.ph_lo = p; a.ph_hi = p + 1; hipLaunchKernelGGL(fwd_kernel, dim3(grid), dim3(NWAVES * 64), LDS_BYTES, stream, a); }
#endif
}
```
